# Optimizing an MI355X kernel written in HIP

```python
import math
import jax, jax.numpy as jnp
from jax import lax
import numpy as np

D_MODEL = 1024
BATCH = 8
SEQ = 2048
DEPTH = 2

CHUNK = 128
A_GROUPS = 4
A_GROUP_DIM = 128
A_WIDTH = A_GROUPS * A_GROUP_DIM
B_HEADS = 4
B_HEAD_DIM = 64
B_VDIM = 2 * B_HEAD_DIM
B_WIDTH = B_HEADS * B_VDIM
Q_BLOCK = 128
C_WINDOWS = (2, 4, 8, 16)
C_GROUPS = len(C_WINDOWS)
C_GROUP_DIM = 128
C_WIDTH = C_GROUPS * C_GROUP_DIM
N_BRANCH = 3
BRANCH_WIDTH = 512
IN_A = 2 * A_WIDTH
IN_Q = B_HEADS * 2 * B_HEAD_DIM
IN_K = B_HEADS * 2 * B_HEAD_DIM
IN_V = B_WIDTH
IN_C = C_WIDTH
IN_G = N_BRANCH * D_MODEL
IN_TOTAL = IN_A + IN_Q + IN_K + IN_V + IN_C + IN_G
SPLITS = tuple(int(s) for s in np.cumsum([IN_A, IN_Q, IN_K, IN_V, IN_C]))
D_FF = -(-8 * D_MODEL // (3 * 256)) * 256
EPS = 1e-6

kernel_name = "hybrid_gated_gmlp_diffattn_pool_block"


def rmsnorm(x, g):
    xf = x.astype(jnp.float32)
    y = xf * lax.rsqrt(jnp.mean(xf * xf, axis=-1, keepdims=True) + EPS)
    return (y * g.astype(jnp.float32)).astype(x.dtype)


def layernorm(x, g, b):
    xf = x.astype(jnp.float32)
    mu = jnp.mean(xf, axis=-1, keepdims=True)
    var = jnp.mean(jnp.square(xf - mu), axis=-1, keepdims=True)
    y = (xf - mu) * lax.rsqrt(var + EPS)
    return (y * g.astype(jnp.float32) + b.astype(jnp.float32)).astype(x.dtype)


def lambda_init_fn(layer_idx):
    return 0.8 - 0.6 * math.exp(-0.3 * layer_idx)


def gmlp_branch(za, vn_g, vn_b, w_s, b_s):
    bsz, s, _ = za.shape
    u, v = jnp.split(za, 2, axis=-1)
    v = layernorm(v, vn_g, vn_b)
    vc = v.reshape(bsz, s // CHUNK, CHUNK, A_GROUPS, A_GROUP_DIM)
    causal = jnp.tril(jnp.ones((CHUNK, CHUNK), dtype=bool))
    ws = jnp.where(causal[None], w_s, jnp.zeros_like(w_s))
    mixed = jnp.einsum('gts,bcsgd->bctgd', ws, vc) + b_s.T[None, None, :, :, None]
    return u * mixed.reshape(bsz, s, A_WIDTH)


def diff_attention(q, k, v, lq1, lk1, lq2, lk2, subln_g, lambda_init):
    bsz, s, _ = q.shape
    q = q.reshape(bsz, s, B_HEADS, 2, B_HEAD_DIM)
    k = k.reshape(bsz, s, B_HEADS, 2, B_HEAD_DIM)
    v = v.reshape(bsz, s, B_HEADS, B_VDIM)
    f32 = jnp.float32
    lam = (jnp.exp(jnp.sum(lq1.astype(f32) * lk1.astype(f32)))
           - jnp.exp(jnp.sum(lq2.astype(f32) * lk2.astype(f32))) + lambda_init)
    scale = B_HEAD_DIM ** -0.5
    nb = s // Q_BLOCK
    qb = jnp.moveaxis(q.reshape(bsz, nb, Q_BLOCK, B_HEADS, 2, B_HEAD_DIM), 1, 0)
    kpos = jnp.arange(s)

    def block(args):
        qblk, i = args
        sc = jnp.einsum('bqhcd,bkhcd->bhcqk', qblk, k).astype(f32) * scale
        qpos = i * Q_BLOCK + jnp.arange(Q_BLOCK)
        mask = kpos[None, :] <= qpos[:, None]
        sc = jnp.where(mask, sc, -jnp.inf)
        p = jax.nn.softmax(sc, axis=-1)
        w = p[:, :, 0] - lam * p[:, :, 1]
        return jnp.einsum('bhqk,bkhe->bqhe', w.astype(v.dtype), v)

    out = lax.map(block, (qb, jnp.arange(nb)))
    out = jnp.moveaxis(out, 0, 1).reshape(bsz, s, B_HEADS, B_VDIM)
    out = rmsnorm(out, subln_g) * (1.0 - lambda_init)
    return out.reshape(bsz, s, B_WIDTH)


def pool_branch(p, w_pool, pool_scale):
    bsz, s, _ = p.shape
    pf = p.astype(jnp.float32)
    csum = jnp.concatenate([jnp.zeros((bsz, 1, C_WIDTH), jnp.float32),
                            lax.cumsum(pf, axis=1)], axis=1)
    t = jnp.arange(s)
    outs = []
    for g, w in enumerate(C_WINDOWS):
        sl = slice(g * C_GROUP_DIM, (g + 1) * C_GROUP_DIM)
        c = csum[..., sl]
        lo = jnp.take(c, jnp.maximum(t + 1 - w, 0), axis=1)
        cnt = jnp.minimum(t + 1, w).astype(jnp.float32)
        outs.append((c[:, 1:] - lo) / cnt[None, :, None] - pf[..., sl])
    pooled = jnp.stack(outs, axis=2).astype(p.dtype)
    y = jnp.einsum('bsgc,gcd->bsgd', pooled, w_pool).reshape(bsz, s, C_WIDTH)
    return y * pool_scale


def setup_inputs(seed: int = 0) -> dict:
    key = jax.random.key(seed)
    ks = jax.random.split(key, 24)
    f32 = jnp.float32
    nrm = lambda k, shape, scale: jax.random.normal(k, shape, f32) * scale
    gain = lambda k, shape: 1.0 + 0.05 * jax.random.normal(k, shape, f32)
    L = DEPTH
    return {
        "x": jax.random.normal(ks[0], (BATCH, SEQ, D_MODEL), f32),
        "norm_mix_pre": gain(ks[1], (L, D_MODEL)),
        "w_in": nrm(ks[2], (L, D_MODEL, IN_TOTAL), D_MODEL ** -0.5),
        "gmlp_norm_g": gain(ks[3], (L, A_WIDTH)),
        "gmlp_norm_b": nrm(ks[4], (L, A_WIDTH), 0.02),
        "gmlp_w_s": nrm(ks[5], (L, A_GROUPS, CHUNK, CHUNK), CHUNK ** -0.5),
        "gmlp_b_s": gain(ks[6], (L, A_GROUPS, CHUNK)),
        "lambda_q1": nrm(ks[7], (L, B_HEAD_DIM), 0.1),
        "lambda_k1": nrm(ks[8], (L, B_HEAD_DIM), 0.1),
        "lambda_q2": nrm(ks[9], (L, B_HEAD_DIM), 0.1),
        "lambda_k2": nrm(ks[10], (L, B_HEAD_DIM), 0.1),
        "diff_subln_g": gain(ks[11], (L, B_VDIM)),
        "pool_w": nrm(ks[12], (L, C_GROUPS, C_GROUP_DIM, C_GROUP_DIM), C_GROUP_DIM ** -0.5),
        "pool_scale": gain(ks[13], (L, C_WIDTH)),
        "w_branch": nrm(ks[14], (L, N_BRANCH, BRANCH_WIDTH, D_MODEL), BRANCH_WIDTH ** -0.5),
        "w_out": nrm(ks[15], (L, D_MODEL, D_MODEL), D_MODEL ** -0.5),
        "norm_mix_post": gain(ks[16], (L, D_MODEL)),
        "norm_ffn_pre": gain(ks[17], (L, D_MODEL)),
        "w_ffn_in": nrm(ks[18], (L, D_MODEL, 2 * D_FF), D_MODEL ** -0.5),
        "w_ffn_out": nrm(ks[19], (L, D_FF, D_MODEL), D_FF ** -0.5),
        "norm_ffn_post": gain(ks[20], (L, D_MODEL)),
    }


def reference(x, norm_mix_pre, w_in, gmlp_norm_g, gmlp_norm_b, gmlp_w_s, gmlp_b_s,
              lambda_q1, lambda_k1, lambda_q2, lambda_k2, diff_subln_g, pool_w,
              pool_scale, w_branch, w_out, norm_mix_post, norm_ffn_pre, w_ffn_in,
              w_ffn_out, norm_ffn_post):
    bsz, s, _ = x.shape
    for l in range(DEPTH):
        h = rmsnorm(x, norm_mix_pre[l])
        z = h @ w_in[l]
        za, zq, zk, zv, zc, zg = jnp.split(z, SPLITS, axis=-1)
        ya = gmlp_branch(jax.nn.gelu(za, approximate=False), gmlp_norm_g[l],
                         gmlp_norm_b[l], gmlp_w_s[l], gmlp_b_s[l])
        yb = diff_attention(zq, zk, zv, lambda_q1[l], lambda_k1[l], lambda_q2[l],
                            lambda_k2[l], diff_subln_g[l], lambda_init_fn(l))
        yc = pool_branch(zc, pool_w[l], pool_scale[l])
        ys = jnp.stack([ya, yb, yc], axis=2)
        up = jnp.einsum('bsnw,nwd->bsnd', ys, w_branch[l])
        gates = jax.nn.sigmoid(zg).reshape(bsz, s, N_BRANCH, D_MODEL)
        merged = jnp.sum(gates * up, axis=2)
        x = x + rmsnorm(merged @ w_out[l], norm_mix_post[l])
        h = rmsnorm(x, norm_ffn_pre[l])
        g, u = jnp.split(h @ w_ffn_in[l], 2, axis=-1)
        f = (jax.nn.silu(g) * u) @ w_ffn_out[l]
        x = x + rmsnorm(f, norm_ffn_post[l])
    return x
```

```cpp
#include <hip/hip_runtime.h>
#include <hip/hip_cooperative_groups.h>
#include <cstdio>
#include <cstdint>
#include <cmath>
namespace cg = cooperative_groups;

typedef unsigned short bf16_t;
typedef short bf16x8 __attribute__((ext_vector_type(8)));
typedef float f32x4 __attribute__((ext_vector_type(4)));
typedef float f32x2 __attribute__((ext_vector_type(2)));
typedef unsigned u32x4 __attribute__((ext_vector_type(4)));
typedef unsigned u32x2 __attribute__((ext_vector_type(2)));
typedef int v4i_t __attribute__((ext_vector_type(4)));
typedef int v8i_t __attribute__((ext_vector_type(8)));

constexpr int NB = 8, SEQ = 2048, DM = 1024, MTOK = NB * SEQ;
constexpr int IN_TOTAL = 6144, DFF = 2816;
constexpr int NWAVES = 8, NTHR = 512;
constexpr float EPS = 1e-6f;
constexpr float C2 = 0.125f * 1.4426950408889634f;
constexpr int LDS_BYTES = 147456;

constexpr size_t MiB = 1u << 20;
constexpr size_t WS_W = 0;
constexpr size_t WS_WIN = 0, WS_WG8 = 6 * MiB, WS_WB = 12 * MiB, WS_WOUT = 15 * MiB, WS_WPOOL = 17 * MiB;
constexpr float WG8_SCALE = 32.0f;
constexpr size_t WS_WF1 = 0, WS_WF2 = 246 * MiB + 512 * 1024;
constexpr size_t WS_ZA = 18 * MiB;
constexpr size_t WS_QKV = 50 * MiB;
constexpr size_t WS_ZC = 98 * MiB;
constexpr size_t WS_P = 50 * MiB;
constexpr size_t WS_MG = 162 * MiB;
constexpr size_t WS_G = 114 * MiB;
constexpr size_t WS_H = 210 * MiB;
constexpr size_t WS_XH = 242 * MiB + 512 * 1024;
constexpr size_t WS_XS = 252 * MiB, XS_BANK = 512 * 1024;
constexpr size_t WS_END = 256 * MiB;
constexpr int CW_SEAM = 4096, SEAM_BANK = 64 * 64;

__device__ __forceinline__ unsigned f2bf(float f) { unsigned u = __builtin_bit_cast(unsigned, f); return (u + 0x7fffu + ((u >> 16) & 1u)) >> 16; }
__device__ __forceinline__ unsigned pk2(float lo, float hi) { unsigned r; asm("v_cvt_pk_bf16_f32 %0, %1, %2" : "=v"(r) : "v"(lo), "v"(hi)); return r; }
__device__ __forceinline__ unsigned pk4_fp8(float a, float b, float c, float d) { int w = 0; w = __builtin_amdgcn_cvt_pk_fp8_f32(a, b, w, false); w = __builtin_amdgcn_cvt_pk_fp8_f32(c, d, w, true); return (unsigned)w; }
__device__ __forceinline__ float bflo(unsigned w) { return __uint_as_float(w << 16); }
__device__ __forceinline__ float bfhi(unsigned w) { return __uint_as_float(w & 0xffff0000u); }
__device__ __forceinline__ float bf1(bf16_t b) { return __uint_as_float(((unsigned)b) << 16); }
__device__ __forceinline__ int fresh_tid(int wave) { int t = wave * 64 + (int)__builtin_amdgcn_mbcnt_hi(~0u, __builtin_amdgcn_mbcnt_lo(~0u, 0u)); asm volatile("" : "+v"(t)); return t; }
__device__ __forceinline__ float wave_sum(float v) {
#pragma unroll
    for (int o = 1; o < 64; o <<= 1) v += __shfl_xor(v, o);
    return v;
}
__device__ __forceinline__ float wave_max(float v) {
#pragma unroll
    for (int o = 1; o < 64; o <<= 1) v = fmaxf(v, __shfl_xor(v, o));
    return v;
}

__device__ __forceinline__ float gelu1(float v) {
    const float av = fabsf(v), t = __builtin_amdgcn_rcpf(av * 0.2316418882f + 1.0f);
    float q = t * 0.5307027145f + (-0.7265760135f); q = q * t + 0.7107068705f; q = q * t + (-0.142248368f); q = q * t + 0.127414796f; q = q * t;
    const float e = __builtin_amdgcn_exp2f((v * v) * (-0.72134752044f));
    const float m = v * (q * e);
    return v < 0.f ? m : v - m;
}
__device__ __forceinline__ float sigmoid1(float v) { return __builtin_amdgcn_rcpf(1.0f + __builtin_amdgcn_exp2f(v * -1.4426950408889634f)); }

struct Unit { int pm, pn, n; const bf16_t* A; const bf16_t* B; };
struct Gemm { int lda; int K; };
__host__ __device__ __forceinline__ int perm32(int rho) { const int n = rho >> 4, i = rho & 15; return 8 * (i >> 2) + 4 * n + (i & 3); }

constexpr int NXCD = 8, WGM = 4;
struct StaticOrder {
    int nM, nN, nwg, G, c; const bf16_t* A; const bf16_t* Bt; size_t atile, btile;
    __device__ void init(int M, int N, int G_, int c_, const bf16_t* A_, int lda, const bf16_t* Bt_, int K) { nM = M / 256; nN = N / 256; nwg = nM * nN; G = G_; c = c_; A = A_; Bt = Bt_; atile = (size_t)256 * lda; btile = (size_t)256 * K; }
    __device__ bool tile(int i, int& pm, int& pn) const {
        const long L = (long)i * G + c; if (L >= nwg) return false;
        int wgid = (int)L; { const int q = nwg / NXCD, r = nwg % NXCD, xcd = wgid % NXCD, off = wgid / NXCD; wgid = (xcd < r ? xcd * (q + 1) : r * (q + 1) + (xcd - r) * q) + off; }
        const int nig = WGM * nN, gid = wgid / nig, fm = gid * WGM, gsz = (nM - fm) < WGM ? (nM - fm) : WGM;
        pm = fm + ((wgid % nig) % gsz); pn = (wgid % nig) / gsz; return true;
    }
    __device__ bool next(int i, Unit& u) const { if (!tile(i, u.pm, u.pn)) return false; u.n = 0; u.A = A + u.pm * atile; u.B = Bt + u.pn * btile; return true; }
};
struct BranchOrder {
    StaticOrder so; const bf16_t* A0; const bf16_t* Bt; size_t bstride;
    __device__ bool next(int i, Unit& u) const {
        const int ti = i / 3, n = i - 3 * ti;
        if (!so.tile(ti, u.pm, u.pn)) return false;
        u.n = n; const size_t aoff = (size_t)(n > 0 ? 1 : 0) * ((WS_H - WS_ZA) / 2) + (size_t)(n > 1 ? 1 : 0) * 512;
        u.A = A0 + aoff + u.pm * so.atile; u.B = Bt + (size_t)n * bstride + u.pn * so.btile; return true;
    }
};

struct EpiIn {
    static constexpr bool PERM = true, AFTER_DRAIN = false, CHAIN = false, FP8 = false;
    bf16_t *ZA, *QKV, *ZC;
    __device__ __forceinline__ void operator()(const f32x4 (&acc)[2][2][4][2], const Unit& u, int wr, int wc, int fr, int fq) const {
        const int pn = u.pn; const int row0 = u.pm * 256 + wr * 64 + fr;
        bf16_t* base; int ldc, colt; bool act = false; float sc = 1.f;
        if (pn < 4) { base = ZA; ldc = 1024; colt = pn * 256; act = true; }
        else if (pn < 10) { base = QKV; ldc = 1536; colt = (pn - 4) * 256; if (pn < 6) sc = C2; }
        else { base = ZC; ldc = 512; colt = (pn - 10) * 256; }
        const int col0 = colt + wc * 32 + 8 * fq;
#pragma unroll
        for (int ai = 0; ai < 2; ++ai)
#pragma unroll
            for (int m = 0; m < 4; ++m) { bf16_t* rowp = base + (size_t)(row0 + ai * 128 + m * 16) * ldc + col0;
#pragma unroll
                for (int bj = 0; bj < 2; ++bj) { f32x4 v0 = acc[ai][bj][m][0], v1 = acc[ai][bj][m][1];
                    if (act) {
#pragma unroll
                        for (int e = 0; e < 4; ++e) { v0[e] = gelu1(v0[e]); v1[e] = gelu1(v1[e]); }
                    }
                    v0 = v0 * sc; v1 = v1 * sc;
                    u32x4 w; w.x = pk2(v0[0], v0[1]); w.y = pk2(v0[2], v0[3]); w.z = pk2(v1[0], v1[1]); w.w = pk2(v1[2], v1[3]);
                    *(u32x4*)(rowp + bj * 128) = w; } }
    }
};
struct EpiGate {
    static constexpr bool PERM = true, AFTER_DRAIN = false, CHAIN = false, FP8 = true;
    unsigned char* G8;
    __device__ __forceinline__ void operator()(const f32x4 (&acc)[2][2][4][2], const Unit& u, int wr, int wc, int fr, int fq) const {
        const int row0 = u.pm * 256 + wr * 64 + fr, col0 = u.pn * 256 + wc * 32 + 8 * fq;
#pragma unroll
        for (int ai = 0; ai < 2; ++ai)
#pragma unroll
            for (int m = 0; m < 4; ++m) { unsigned char* rowp = G8 + (size_t)(row0 + ai * 128 + m * 16) * 3072 + col0;
#pragma unroll
                for (int bj = 0; bj < 2; ++bj) { unsigned q[8];
#pragma unroll
                    for (int e = 0; e < 4; ++e) { q[e] = (unsigned)fminf(sigmoid1(acc[ai][bj][m][0][e] * (1.0f / WG8_SCALE)) * 256.0f, 255.0f); q[4 + e] = (unsigned)fminf(sigmoid1(acc[ai][bj][m][1][e] * (1.0f / WG8_SCALE)) * 256.0f, 255.0f); }
                    u32x2 w; w.x = q[0] | (q[1] << 8) | (q[2] << 16) | (q[3] << 24); w.y = q[4] | (q[5] << 8) | (q[6] << 16) | (q[7] << 24);
                    *(u32x2*)(rowp + bj * 128) = w; } }
    }
};
__device__ __forceinline__ void gate8(const u32x2 w, f32x4& g0, f32x4& g1) {
    g0 = (f32x4){(float)(w.x & 0xffu), (float)((w.x >> 8) & 0xffu), (float)((w.x >> 16) & 0xffu), (float)(w.x >> 24)};
    g1 = (f32x4){(float)(w.y & 0xffu), (float)((w.y >> 8) & 0xffu), (float)((w.y >> 16) & 0xffu), (float)(w.y >> 24)};
    g0 = g0 * (1.0f / 256.0f) + (0.5f / 256.0f); g1 = g1 * (1.0f / 256.0f) + (0.5f / 256.0f);
}
struct EpiBranch {
    static constexpr bool PERM = true, AFTER_DRAIN = false, CHAIN = true, FP8 = false;
    const unsigned char* G8; bf16_t* MG;
    __device__ __forceinline__ void operator()(f32x4 (&acc)[2][2][4][2], const Unit& u, int wr, int wc, int fr, int fq) const {
        const int n = u.n; const int row0 = u.pm * 256 + wr * 64 + fr, col0 = u.pn * 256 + wc * 32 + 8 * fq;
#pragma unroll
        for (int ai = 0; ai < 2; ++ai)
#pragma unroll
            for (int m = 0; m < 4; ++m) { const size_t row = (size_t)(row0 + ai * 128 + m * 16);
#pragma unroll
                for (int bj = 0; bj < 2; ++bj) { const int col = col0 + bj * 128;
                    const unsigned char* gp = G8 + row * 3072 + n * 1024 + col;
                    f32x4 g0, g1; gate8(*(const u32x2*)gp, g0, g1);
                    if (n < 2) { f32x4 h0, h1; gate8(*(const u32x2*)(gp + 1024), h0, h1);
#pragma unroll
                        for (int e = 0; e < 4; ++e) { g0[e] *= __builtin_amdgcn_rcpf(h0[e]); g1[e] *= __builtin_amdgcn_rcpf(h1[e]); }
                        acc[ai][bj][m][0] *= g0; acc[ai][bj][m][1] *= g1;
                    } else { const f32x4 v0 = acc[ai][bj][m][0] * g0, v1 = acc[ai][bj][m][1] * g1;
                        u32x4 w; w.x = pk2(v0[0], v0[1]); w.y = pk2(v0[2], v0[3]); w.z = pk2(v1[0], v1[1]); w.w = pk2(v1[2], v1[3]); *(u32x4*)(MG + row * 1024 + col) = w; } } }
    }
};
struct EpiF32 {
    static constexpr bool PERM = true, AFTER_DRAIN = false, CHAIN = false, FP8 = false;
    float* O;
    __device__ __forceinline__ void operator()(const f32x4 (&acc)[2][2][4][2], const Unit& u, int wr, int wc, int fr, int fq) const {
        const int row0 = u.pm * 256 + wr * 64 + fr, col0 = u.pn * 256 + wc * 32 + 8 * fq;
#pragma unroll
        for (int ai = 0; ai < 2; ++ai)
#pragma unroll
            for (int m = 0; m < 4; ++m) { float* rowp = O + (size_t)(row0 + ai * 128 + m * 16) * 1024 + col0;
#pragma unroll
                for (int bj = 0; bj < 2; ++bj) { *(f32x4*)(rowp + bj * 128) = acc[ai][bj][m][0]; *(f32x4*)(rowp + bj * 128 + 4) = acc[ai][bj][m][1]; } }
    }
};
struct EpiSwiglu {
    static constexpr bool PERM = true, AFTER_DRAIN = false, CHAIN = false, FP8 = false;
    bf16_t* F;
    __device__ __forceinline__ void operator()(const f32x4 (&acc)[2][2][4][2], const Unit& u, int wr, int wc, int fr, int fq) const {
        const int row0 = u.pm * 256 + wr * 64 + fr, col0 = u.pn * 128 + wc * 32 + 8 * fq;
#pragma unroll
        for (int ai = 0; ai < 2; ++ai)
#pragma unroll
            for (int m = 0; m < 4; ++m) { bf16_t* rowp = F + (size_t)(row0 + ai * 128 + m * 16) * DFF + col0;
                f32x4 v0, v1;
#pragma unroll
                for (int e = 0; e < 4; ++e) { const float g0 = acc[ai][0][m][0][e], g1 = acc[ai][0][m][1][e];
                    v0[e] = g0 * sigmoid1(g0) * acc[ai][1][m][0][e]; v1[e] = g1 * sigmoid1(g1) * acc[ai][1][m][1][e]; }
                u32x4 w; w.x = pk2(v0[0], v0[1]); w.y = pk2(v0[2], v0[3]); w.z = pk2(v1[0], v1[1]); w.w = pk2(v1[2], v1[3]);
                *(u32x4*)rowp = w; }
    }
};

#define EX_LAS __attribute__((address_space(3)))
struct PanelRms {
    unsigned long long* xbuf;
    __device__ __forceinline__ void run(const f32x4 (&v)[2][2][4][2], const Unit& u, int wr, int wc, int fr, int fq, EX_LAS unsigned char* lds, int wid, int lane) const {
        EX_LAS float* P = (EX_LAS float*)lds;
        EX_LAS float* S = (EX_LAS float*)(lds + 4096);
#pragma unroll
        for (int ai = 0; ai < 2; ++ai)
#pragma unroll
            for (int m = 0; m < 4; ++m) {
                float q = 0.f;
#pragma unroll
                for (int bj = 0; bj < 2; ++bj)
#pragma unroll
                    for (int n = 0; n < 2; ++n) { const f32x4 x = v[ai][bj][m][n]; q += (x[0] * x[0] + x[1] * x[1]) + (x[2] * x[2] + x[3] * x[3]); }
                q += __shfl_xor(q, 16); q += __shfl_xor(q, 32);
                if (fq == 0) P[(ai * 128 + wr * 64 + m * 16 + fr) * 4 + wc] = q;
            }
        asm volatile("s_waitcnt lgkmcnt(0)" ::: "memory"); __builtin_amdgcn_s_barrier(); asm volatile("" ::: "memory");
        const int row = wid * 32 + (lane & 31);
        if (lane < 32) {
            const float tot = (P[row * 4 + 0] + P[row * 4 + 1]) + (P[row * 4 + 2] + P[row * 4 + 3]);
            unsigned long long* slot = xbuf + (size_t)(u.pm * 256 + row) * 4;
            __hip_atomic_store(slot + u.pn, (1ull << 32) | (unsigned long long)__float_as_uint(tot), __ATOMIC_RELAXED, __HIP_MEMORY_SCOPE_AGENT);
            float ss = 0.f;
#pragma unroll
            for (int t = 0; t < 4; ++t) { unsigned long long w = 0ull;
#pragma unroll 1
                for (unsigned it = 0; it < (1u << 20); ++it) { w = __hip_atomic_load(slot + t, __ATOMIC_RELAXED, __HIP_MEMORY_SCOPE_AGENT); if ((w >> 32) != 0ull) break; __builtin_amdgcn_s_sleep(1); }
                ss += __uint_as_float((unsigned)w); }
            S[row] = 1.0f / sqrtf(ss * (1.0f / 1024.0f) + EPS);
        }
        asm volatile("s_waitcnt vmcnt(0) lgkmcnt(0)" ::: "memory"); __builtin_amdgcn_s_barrier(); asm volatile("" ::: "memory");
    }
};
template <bool BASE_BF>
struct EpiRmsRes {
    static constexpr bool PERM = true, AFTER_DRAIN = true, CHAIN = false, FP8 = false;
    const void* base; float* out_f32; bf16_t* out_bf; const float* gpost; const float* gnext; bf16_t* xn; unsigned char* xn8; PanelRms st1, st2; unsigned* wait_word; unsigned wait_val;
    __device__ __forceinline__ void operator()(const f32x4 (&)[2][2][4][2], const Unit&, int, int, int, int) const {}
    __device__ __forceinline__ void fused(f32x4 (&acc)[2][2][4][2], const Unit& u, int wr, int wc, int fr, int fq, EX_LAS unsigned char* lds, int wid, int lane) const {
        const EX_LAS float* S = (const EX_LAS float*)(lds + 4096);
        const int col0 = u.pn * 256 + wc * 32 + 8 * fq;
        if (wait_word && wid == 0) {
#pragma unroll 1
            for (unsigned it = 0; it < (1u << 21); ++it) { if ((unsigned)__builtin_amdgcn_readfirstlane(__hip_atomic_load(wait_word, __ATOMIC_RELAXED, __HIP_MEMORY_SCOPE_AGENT)) >= wait_val) break; __builtin_amdgcn_s_sleep(2); }
        }
        u32x4 preb[2][4][2]; f32x4 pref[4][2][2];
        if constexpr (BASE_BF) {
#pragma unroll
            for (int ai = 0; ai < 2; ++ai)
#pragma unroll
                for (int m = 0; m < 4; ++m) { const size_t off = (size_t)(u.pm * 256 + ai * 128 + wr * 64 + m * 16 + fr) * 1024 + col0;
#pragma unroll
                    for (int bj = 0; bj < 2; ++bj) preb[ai][m][bj] = *(const u32x4*)((const bf16_t*)base + off + bj * 128); }
        } else {
#pragma unroll
            for (int m = 0; m < 4; ++m) { const size_t off = (size_t)(u.pm * 256 + wr * 64 + m * 16 + fr) * 1024 + col0;
#pragma unroll
                for (int bj = 0; bj < 2; ++bj)
#pragma unroll
                    for (int n = 0; n < 2; ++n) pref[m][bj][n] = *(const f32x4*)((const float*)base + off + bj * 128 + n * 4); }
        }
        st1.run(acc, u, wr, wc, fr, fq, lds, wid, lane);
#pragma unroll
        for (int ai = 0; ai < 2; ++ai)
#pragma unroll
            for (int m = 0; m < 4; ++m) { const int r = ai * 128 + wr * 64 + m * 16 + fr; const float sr = S[r]; const size_t off = (size_t)(u.pm * 256 + r) * 1024 + col0;
#pragma unroll
                for (int bj = 0; bj < 2; ++bj) {
                    f32x4 b0, b1;
                    if constexpr (BASE_BF) { const u32x4 w = preb[ai][m][bj]; b0 = (f32x4){bflo(w.x), bfhi(w.x), bflo(w.y), bfhi(w.y)}; b1 = (f32x4){bflo(w.z), bfhi(w.z), bflo(w.w), bfhi(w.w)}; }
                    else { b0 = (ai == 0) ? pref[m][bj][0] : *(const f32x4*)((const float*)base + off + bj * 128); b1 = (ai == 0) ? pref[m][bj][1] : *(const f32x4*)((const float*)base + off + bj * 128 + 4); }
                    const f32x4 g0 = *(const f32x4*)(gpost + col0 + bj * 128), g1 = *(const f32x4*)(gpost + col0 + bj * 128 + 4);
                    acc[ai][bj][m][0] = b0 + acc[ai][bj][m][0] * sr * g0; acc[ai][bj][m][1] = b1 + acc[ai][bj][m][1] * sr * g1; }
                asm volatile("" : "+v"(acc[ai][0][m][0]), "+v"(acc[ai][0][m][1]), "+v"(acc[ai][1][m][0]), "+v"(acc[ai][1][m][1]));
                if (m & 1) asm volatile("" ::: "memory"); }
        if (gnext) st2.run(acc, u, wr, wc, fr, fq, lds, wid, lane);
#pragma unroll
        for (int ai = 0; ai < 2; ++ai)
#pragma unroll
            for (int m = 0; m < 4; ++m) { const int r = ai * 128 + wr * 64 + m * 16 + fr; const float sr = S[r]; const size_t off = (size_t)(u.pm * 256 + r) * 1024 + col0;
#pragma unroll
                for (int bj = 0; bj < 2; ++bj) { const f32x4 x0 = acc[ai][bj][m][0], x1 = acc[ai][bj][m][1];
                    if (out_f32) { *(f32x4*)(out_f32 + off + bj * 128) = x0; *(f32x4*)(out_f32 + off + bj * 128 + 4) = x1; }
                    else { u32x4 w; w.x = pk2(x0[0], x0[1]); w.y = pk2(x0[2], x0[3]); w.z = pk2(x1[0], x1[1]); w.w = pk2(x1[2], x1[3]); *(u32x4*)(out_bf + off + bj * 128) = w; }
                    if (gnext) { const f32x4 g0 = *(const f32x4*)(gnext + col0 + bj * 128), g1 = *(const f32x4*)(gnext + col0 + bj * 128 + 4);
                        const f32x4 h0 = x0 * sr * g0, h1 = x1 * sr * g1;
                        u32x4 w; w.x = pk2(h0[0], h0[1]); w.y = pk2(h0[2], h0[3]); w.z = pk2(h1[0], h1[1]); w.w = pk2(h1[2], h1[3]);
                        *(u32x4*)(xn + off + bj * 128) = w;
                        if (xn8) { u32x2 w8; w8.x = pk4_fp8(h0[0], h0[1], h0[2], h0[3]); w8.y = pk4_fp8(h1[0], h1[1], h1[2], h1[3]); *(u32x2*)(xn8 + off + bj * 128) = w8; } } }
                asm volatile("" ::: "memory"); }
    }
};

#define PG8_LAS __attribute__((address_space(3)))
constexpr int BK = 64, HALF = 128, HTB = HALF * BK * 2, STAGE_BYTES = 8 * HTB;
__host__ __device__ __forceinline__ int lds_byte(int r, int c) { const int st = (r >> 4) * 2 + (c >> 5), rr = r & 15, cc = c & 31, ob = rr * 64 + cc * 2; return st * 1024 + (ob ^ (((ob >> 9) & 1) << 5)); }
__host__ __device__ __forceinline__ void stage_rc(int b, int& R, int& C) { const int st = b / 1024, sb = b % 1024, swz = sb ^ (((sb >> 9) & 1) << 5); R = (st >> 1) * 16 + swz / 64; C = (st & 1) * 32 + (swz % 64) / 2; }

template <class Epi, class Sched>
__device__ __forceinline__ void gemm_phase(PG8_LAS unsigned char* lds, const Gemm g, const Sched& S, const Epi& E, int wave_) {
    const int tid_ = fresh_tid(wave_);
    const int tid = tid_, wid = __builtin_amdgcn_readfirstlane(tid >> 6), lane = tid & 63, wr = wid >> 2, wc = wid & 3, fr = lane & 15, fq = lane >> 4;
    const int K = g.K, nt = K / BK;
    unsigned voffA[2], voffB[2];
#pragma unroll
    for (int i = 0; i < 2; ++i) { int R, C; stage_rc(tid * 16 + i * 8192, R, C); const int Rb = Epi::PERM ? ((R & ~31) + perm32(R & 31)) : R;
        voffA[i] = (unsigned)(R * g.lda + C) * 2u; voffB[i] = (unsigned)(Rb * K + C) * 2u; }
    const size_t kstep = (size_t)(BK * 2);
    const size_t hstepA = (size_t)HALF * g.lda * 2, hstepB = (size_t)HALF * K * 2;
    const unsigned ldsw = (unsigned)wid * 1024u;
    const int aoff = lds_byte(wr * 64 + fr, fq * 8), boff = lds_byte(wc * 32 + fr, fq * 8);
#define PG8_SA(b, h) (((b) * 2 + (h)) * HTB)
#define PG8_SB(b, h) ((4 + (b) * 2 + (h)) * HTB)
#define PG8_STAGE(bufoff, gbase, voff) do { _Pragma("unroll") for (int _i = 0; _i < 2; ++_i) \
        __builtin_amdgcn_global_load_lds((const unsigned*)((const char*)(gbase) + (voff)[_i]), (PG8_LAS unsigned*)(lds + (bufoff) + ldsw + _i * 8192), 16, 0, 0); } while (0)
    PG8_LAS unsigned char* const fa = lds + aoff; PG8_LAS unsigned char* fb_ = lds + 4 * HTB + boff; asm volatile("" : "+v"(fb_)); PG8_LAS unsigned char* const fb = fb_;
#define PG8_FA(b, h) (((b) * 2 + (h)) * HTB)
#define PG8_FB(b, h) (((b) * 2 + (h)) * HTB)
#define PG8_LDA(dst, b, h) do { if constexpr (Epi::FP8) { _Pragma("unroll") for (int m = 0; m < 4; ++m) dst##8[m] = __builtin_shufflevector(*(const PG8_LAS v4i_t*)(fa + PG8_FA(b, h) + m * 2048), *(const PG8_LAS v4i_t*)(fa + PG8_FA(b, h) + m * 2048 + 1024), 0, 1, 2, 3, 4, 5, 6, 7); } \
        else { _Pragma("unroll") for (int m = 0; m < 4; ++m) _Pragma("unroll") for (int k = 0; k < 2; ++k) dst[m][k] = *(const PG8_LAS bf16x8*)(fa + PG8_FA(b, h) + m * 2048 + k * 1024); } } while (0)
#define PG8_LDB(dst, b, h) do { if constexpr (Epi::FP8) { _Pragma("unroll") for (int n = 0; n < 2; ++n) dst##8[n] = __builtin_shufflevector(*(const PG8_LAS v4i_t*)(fb + PG8_FB(b, h) + n * 2048), *(const PG8_LAS v4i_t*)(fb + PG8_FB(b, h) + n * 2048 + 1024), 0, 1, 2, 3, 4, 5, 6, 7); } \
        else { _Pragma("unroll") for (int n = 0; n < 2; ++n) _Pragma("unroll") for (int k = 0; k < 2; ++k) dst[n][k] = *(const PG8_LAS bf16x8*)(fb + PG8_FB(b, h) + n * 2048 + k * 1024); } } while (0)
#define PG8_MMA(ai, bj, At, Bt) do { __builtin_amdgcn_s_setprio(1); \
        if constexpr (Epi::FP8) { _Pragma("unroll") for (int m = 0; m < 4; ++m) _Pragma("unroll") for (int n = 0; n < 2; ++n) \
            asm volatile("v_mfma_f32_16x16x128_f8f6f4 %0, %1, %2, %0" : "+v"(acc[ai][bj][m][n]) : "v"(Bt##8[n]), "v"(At##8[m])); }   \
        else { _Pragma("unroll") for (int m = 0; m < 4; ++m) _Pragma("unroll") for (int n = 0; n < 2; ++n) _Pragma("unroll") for (int k = 0; k < 2; ++k) \
            acc[ai][bj][m][n] = __builtin_amdgcn_mfma_f32_16x16x32_bf16(Bt[n][k], At[m][k], acc[ai][bj][m][n], 0, 0, 0); } \
        __builtin_amdgcn_s_setprio(0); } while (0)
#define PG8_WAIT_V(n) asm volatile("s_waitcnt vmcnt(" #n ")" ::: "memory")
#define PG8_WAIT_L(n) asm volatile("s_waitcnt lgkmcnt(" #n ")" ::: "memory")
#define PG8_BAR __builtin_amdgcn_s_barrier()
#define PG8_SCHED __builtin_amdgcn_sched_barrier(0)
    Unit cur, nxt; int ui = 0;
    if (!S.next(0, cur)) return;
    f32x4 acc[2][2][4][2];
#pragma unroll
    for (int a = 0; a < 2; ++a)
#pragma unroll
        for (int b = 0; b < 2; ++b)
#pragma unroll
            for (int m = 0; m < 4; ++m)
#pragma unroll
                for (int n = 0; n < 2; ++n) acc[a][b][m][n] = (f32x4){0.f, 0.f, 0.f, 0.f};
    bf16x8 At[4][2], B0[2][2], B1[2][2]; v8i_t At8[4], B08[2], B18[2];
    const char* cA = (const char*)cur.A; const char* cB = (const char*)cur.B;
    PG8_STAGE(PG8_SB(0, 0), cB, voffB); PG8_STAGE(PG8_SB(0, 1), cB + hstepB, voffB); PG8_STAGE(PG8_SA(0, 0), cA, voffA); PG8_STAGE(PG8_SA(0, 1), cA + hstepA, voffA);
    if (wr == 1) PG8_BAR;
    PG8_WAIT_V(2); PG8_BAR;
    PG8_STAGE(PG8_SB(1, 0), cB + kstep, voffB); PG8_STAGE(PG8_SA(1, 0), cA + kstep, voffA); PG8_STAGE(PG8_SB(1, 1), cB + hstepB + kstep, voffB);
    PG8_WAIT_V(6); PG8_BAR;
    for (;;) {
        const bool has_next = S.next(ui + 1, nxt);
        const char* nA = has_next ? (const char*)nxt.A : cA; const char* nB = has_next ? (const char*)nxt.B : cB;
#pragma unroll 1
        for (int t = 0; t < nt; t += 2) {
            const bool last = (t == nt - 2);
            const char* a1 = cA + (size_t)(t + 1) * kstep;
            const char* a2 = last ? nA : cA + (size_t)(t + 2) * kstep; const char* b2 = last ? nB : cB + (size_t)(t + 2) * kstep;
            const char* a3 = a2 + kstep; const char* b3 = b2 + kstep;
            PG8_LDB(B0, 0, 0); PG8_LDB(B1, 0, 1); PG8_SCHED; PG8_LDA(At, 0, 0); PG8_STAGE(PG8_SA(1, 1), a1 + hstepA, voffA);
            PG8_WAIT_V(8); PG8_WAIT_L(0); PG8_BAR; PG8_MMA(0, 0, At, B0); PG8_MMA(0, 1, At, B1); PG8_BAR; PG8_SCHED;
            PG8_LDA(At, 0, 1); PG8_STAGE(PG8_SB(0, 0), b2, voffB); PG8_STAGE(PG8_SB(0, 1), b2 + hstepB, voffB); PG8_STAGE(PG8_SA(0, 0), a2, voffA);
            PG8_WAIT_V(8); PG8_WAIT_L(0); PG8_BAR; PG8_MMA(1, 0, At, B0); PG8_MMA(1, 1, At, B1); PG8_BAR; PG8_SCHED;
            PG8_LDB(B0, 1, 0); PG8_LDB(B1, 1, 1); PG8_SCHED; PG8_LDA(At, 1, 0); PG8_STAGE(PG8_SA(0, 1), a2 + hstepA, voffA);
            PG8_WAIT_V(8); PG8_WAIT_L(0); PG8_BAR; PG8_MMA(0, 0, At, B0); PG8_MMA(0, 1, At, B1); PG8_BAR; PG8_SCHED;
            PG8_LDA(At, 1, 1); PG8_STAGE(PG8_SB(1, 0), b3, voffB); PG8_STAGE(PG8_SB(1, 1), b3 + hstepB, voffB); PG8_STAGE(PG8_SA(1, 0), a3, voffA);
            PG8_WAIT_V(8); PG8_WAIT_L(0); PG8_BAR; PG8_MMA(1, 0, At, B0); PG8_MMA(1, 1, At, B1); PG8_BAR; PG8_SCHED;
        }
        if (wr == 0) PG8_BAR;
        if constexpr (Epi::FP8) asm volatile("s_nop 15\n\ts_nop 15" ::: "memory");
        if constexpr (!Epi::AFTER_DRAIN) E(acc, cur, wr, wc, fr, fq);
        if (!has_next) break;
        if (!Epi::CHAIN || cur.n == 2) {
#pragma unroll
            for (int a = 0; a < 2; ++a)
#pragma unroll
                for (int b = 0; b < 2; ++b)
#pragma unroll
                    for (int m = 0; m < 4; ++m)
#pragma unroll
                        for (int n = 0; n < 2; ++n) acc[a][b][m][n] = (f32x4){0.f, 0.f, 0.f, 0.f};
        }
        cur = nxt; cA = nA; cB = nB; ++ui;
        if (wr == 1) PG8_BAR;
    }
    PG8_WAIT_V(0);
    PG8_BAR;
    if constexpr (Epi::AFTER_DRAIN) E.fused(acc, cur, wr, wc, fr, fq, lds, wid, lane);
#undef PG8_SA
#undef PG8_SB
#undef PG8_STAGE
#undef PG8_LDA
#undef PG8_LDB
#undef PG8_MMA
#undef PG8_FA
#undef PG8_FB
#undef PG8_WAIT_V
#undef PG8_WAIT_L
#undef PG8_BAR
#undef PG8_SCHED
}
#define GEMM_PHASE(EpiT, SchedT, g, S, E) gemm_phase<EpiT, SchedT>((PG8_LAS unsigned char*)lds, g, S, E, my_wave)

struct Ctx {
    unsigned char* lds; int tid, lane, wave, gw, ngw;
};
struct TDesc { const float* W; bf16_t* WT; int K, N, mode, item; };
__device__ __forceinline__ void titem_load(const TDesc& d, int lane, f32x4 (&v)[8]) {
    const int nblk = d.N / 32, kb = d.item / nblk, nb = d.item % nblk, k0 = 64 * kb, n0 = 32 * nb;
#pragma unroll
    for (int i = 0; i < 8; ++i) v[i] = __builtin_nontemporal_load((const f32x4*)(d.W + (size_t)(k0 + 8 * i + (lane >> 3)) * d.N + n0 + 4 * (lane & 7)));
}
__device__ __forceinline__ void titem_store(const TDesc& d, int lane, const f32x4 (&v)[8], float* scr) {
    const int nblk = d.N / 32, kb = d.item / nblk, nb = d.item % nblk, k0 = 64 * kb, n0 = 32 * nb;
#pragma unroll
    for (int i = 0; i < 8; ++i) { float* q = scr + (8 * i + (lane >> 3)) * 33 + 4 * (lane & 7); q[0] = v[i][0]; q[1] = v[i][1]; q[2] = v[i][2]; q[3] = v[i][3]; }
    __builtin_amdgcn_wave_barrier(); asm volatile("s_waitcnt lgkmcnt(0)" ::: "memory");
    int d0 = n0;
    if (d.mode == 1) { const int half = d.N / 2; const int j = (n0 < half) ? n0 : n0 - half; d0 = (j / 128) * 256 + (j % 128) + ((n0 < half) ? 0 : 128); }
    const int c = lane & 7;
#pragma unroll
    for (int j = 0; j < 4; ++j) { const int n = (lane >> 3) + 8 * j; const float* sp = scr + (8 * c) * 33 + n;
        if (d.mode == 2) {
            u32x2 o; o.x = pk4_fp8(sp[0 * 33] * WG8_SCALE, sp[1 * 33] * WG8_SCALE, sp[2 * 33] * WG8_SCALE, sp[3 * 33] * WG8_SCALE); o.y = pk4_fp8(sp[4 * 33] * WG8_SCALE, sp[5 * 33] * WG8_SCALE, sp[6 * 33] * WG8_SCALE, sp[7 * 33] * WG8_SCALE);
            *(u32x2*)((unsigned char*)d.WT + (size_t)(d0 - d.N / 2 + n) * d.K + k0 + 8 * c) = o; continue; }
        u32x4 o; o.x = pk2(sp[0 * 33], sp[1 * 33]); o.y = pk2(sp[2 * 33], sp[3 * 33]); o.z = pk2(sp[4 * 33], sp[5 * 33]); o.w = pk2(sp[6 * 33], sp[7 * 33]);
        *(u32x4*)(d.WT + (size_t)(d0 + n) * d.K + k0 + 8 * c) = o; }
    __builtin_amdgcn_wave_barrier(); asm volatile("s_waitcnt lgkmcnt(0)" ::: "memory");
}
struct MixerW { const float *w_in, *w_branch, *w_out, *pool_w; unsigned char* ws;
    static constexpr int I_IN = 16 * 192, I_B = 8 * 32, I_O = 16 * 32, I_P = 2 * 4, NIT = I_IN + 3 * I_B + I_O + 4 * I_P;
    __device__ __forceinline__ TDesc desc(int it) const {
        int r = it;
        if (r < I_IN) { const bool gate = (r % 192) >= 96;
            return TDesc{w_in, (bf16_t*)(ws + (gate ? WS_WG8 : WS_WIN)), 1024, IN_TOTAL, gate ? 2 : 0, r}; }
        r -= I_IN;
        if (r < 3 * I_B) { const int n = r / I_B; return TDesc{w_branch + (size_t)n * 512 * 1024, (bf16_t*)(ws + WS_WB) + (size_t)n * 1024 * 512, 512, 1024, 0, r % I_B}; }
        r -= 3 * I_B;
        if (r < I_O) return TDesc{w_out, (bf16_t*)(ws + WS_WOUT), 1024, 1024, 0, r};
        r -= I_O;
        { const int g = r / I_P; return TDesc{pool_w + (size_t)g * 128 * 128, (bf16_t*)(ws + WS_WPOOL) + (size_t)g * 128 * 128, 128, 128, 0, r % I_P}; }
    }
};
struct FfnW { const float *w1, *w2; unsigned char* ws;
    static constexpr int I_1 = 16 * 176, I_2 = 44 * 32, NIT = I_1 + I_2;
    __device__ __forceinline__ TDesc desc(int it) const {
        if (it < I_1) return TDesc{w1, (bf16_t*)(ws + WS_WF1), 1024, 2 * DFF, 1, it};
        return TDesc{w2, (bf16_t*)(ws + WS_WF2), DFF, 1024, 0, it - I_1};
    }
};
template <class Wset>
__device__ __forceinline__ void convert_weights(const Ctx& C, const Wset& ww) {
    float* scr = (float*)(C.lds + C.wave * 16384);
    int it = C.gw; if (it >= Wset::NIT) return;
    TDesc d = ww.desc(it); f32x4 v[8]; titem_load(d, C.lane, v);
#pragma unroll 1
    for (;;) {
        const int nx = it + C.ngw; const bool hn = nx < Wset::NIT;
        TDesc dn = d; f32x4 vn[8];
        if (hn) { dn = ww.desc(nx); titem_load(dn, C.lane, vn); }
        titem_store(d, C.lane, v, scr);
        if (!hn) break;
        d = dn; it = nx;
#pragma unroll
        for (int i = 0; i < 8; ++i) v[i] = vn[i];
    }
}
__device__ __forceinline__ void convert_mixer_weights(const Ctx& C, const float* w_in, const float* w_branch, const float* w_out, const float* pool_w, unsigned char* ws) {
    convert_weights(C, MixerW{w_in, w_branch, w_out, pool_w, ws});
}
__device__ __forceinline__ void convert_ffn_weights(const Ctx& C, const float* w1, const float* w2, unsigned char* ws) {
    convert_weights(C, FfnW{w1, w2, ws});
}
__device__ __forceinline__ void rms_rows4_to_bf16(const float* x, const float* g, bf16_t* h, unsigned char* h8, int m0, int mstep, int lane) {
    f32x4 v[4][4]; float ss[4];
#pragma unroll
    for (int r = 0; r < 4; ++r) { const int m = m0 + r * mstep; const bool ok = m < MTOK; ss[r] = 0.f;
#pragma unroll
        for (int j = 0; j < 4; ++j) { v[r][j] = ok ? *((const f32x4*)(x + (size_t)m * DM) + lane + 64 * j) : (f32x4){0.f, 0.f, 0.f, 0.f}; } }
#pragma unroll
    for (int r = 0; r < 4; ++r) {
#pragma unroll
        for (int j = 0; j < 4; ++j) ss[r] += (v[r][j][0] * v[r][j][0] + v[r][j][1] * v[r][j][1]) + (v[r][j][2] * v[r][j][2] + v[r][j][3] * v[r][j][3]);
        ss[r] = wave_sum(ss[r]); }
#pragma unroll
    for (int r = 0; r < 4; ++r) { const int m = m0 + r * mstep; if (m >= MTOK) continue;
        const float rstd = 1.0f / sqrtf(ss[r] * (1.f / DM) + EPS);
#pragma unroll
        for (int j = 0; j < 4; ++j) { const f32x4 gg = *((const f32x4*)g + lane + 64 * j); const f32x4 o = v[r][j] * rstd * gg;
            u32x2 w; w.x = pk2(o[0], o[1]); w.y = pk2(o[2], o[3]); *((u32x2*)(h + (size_t)m * DM) + lane + 64 * j) = w;
            *((unsigned*)(h8 + (size_t)m * DM) + lane + 64 * j) = pk4_fp8(o[0], o[1], o[2], o[3]); } }
}
__device__ __forceinline__ void rms_row_to_bf16(const float* xrow, const float* g, bf16_t* hrow, int lane) {
    f32x4 v[4]; float ss = 0.f;
#pragma unroll
    for (int j = 0; j < 4; ++j) { v[j] = *((const f32x4*)xrow + lane + 64 * j); ss += (v[j][0] * v[j][0] + v[j][1] * v[j][1]) + (v[j][2] * v[j][2] + v[j][3] * v[j][3]); }
    const float rstd = 1.0f / sqrtf(wave_sum(ss) * (1.f / DM) + EPS);
#pragma unroll
    for (int j = 0; j < 4; ++j) { const f32x4 gg = *((const f32x4*)g + lane + 64 * j); const f32x4 o = v[j] * rstd * gg;
        u32x2 w; w.x = pk2(o[0], o[1]); w.y = pk2(o[2], o[3]); *((u32x2*)hrow + lane + 64 * j) = w; }
}
__device__ __forceinline__ void res_norm_row(const float* orow, const float* xin, float* xout, const float* gpost, const float* gnext, bf16_t* hrow, unsigned char* h8row, int lane) {
    f32x4 o[4], x[4]; float ss = 0.f;
#pragma unroll
    for (int j = 0; j < 4; ++j) { o[j] = *((const f32x4*)orow + lane + 64 * j); x[j] = *((const f32x4*)xin + lane + 64 * j); ss += (o[j][0] * o[j][0] + o[j][1] * o[j][1]) + (o[j][2] * o[j][2] + o[j][3] * o[j][3]); }
    const float rstd = 1.0f / sqrtf(wave_sum(ss) * (1.f / DM) + EPS);
    float s2 = 0.f;
#pragma unroll
    for (int j = 0; j < 4; ++j) { const f32x4 gg = *((const f32x4*)gpost + lane + 64 * j); x[j] = x[j] + o[j] * rstd * gg; *((f32x4*)xout + lane + 64 * j) = x[j];
        s2 += (x[j][0] * x[j][0] + x[j][1] * x[j][1]) + (x[j][2] * x[j][2] + x[j][3] * x[j][3]); }
    if (gnext) {
        const float r2 = 1.0f / sqrtf(wave_sum(s2) * (1.f / DM) + EPS);
#pragma unroll
        for (int j = 0; j < 4; ++j) { const f32x4 gg = *((const f32x4*)gnext + lane + 64 * j); const f32x4 h = x[j] * r2 * gg;
            u32x2 w; w.x = pk2(h[0], h[1]); w.y = pk2(h[2], h[3]); *((u32x2*)hrow + lane + 64 * j) = w;
            if (h8row) *((unsigned*)h8row + lane + 64 * j) = pk4_fp8(h[0], h[1], h[2], h[3]); }
    }
}

constexpr int LP = 136;
template <bool CAUSAL>
__device__ __forceinline__ void mm128(const bf16_t* Pl, const bf16_t* Ql, int w, int r, int q, f32x4 (&acc)[8]) {
#pragma unroll
    for (int rb = 0; rb < 8; ++rb) acc[rb] = (f32x4){0.f, 0.f, 0.f, 0.f};
#pragma unroll
    for (int kb = 0; kb < 4; ++kb) {
        const bf16x8 p = *(const bf16x8*)(Pl + (16 * w + r) * LP + 32 * kb + 8 * q);
#pragma unroll
        for (int rb = 0; rb < 8; ++rb) {
            if (CAUSAL && rb < 2 * kb) continue;
            const bf16x8 qq = *(const bf16x8*)(Ql + (16 * rb + r) * LP + 32 * kb + 8 * q);
            acc[rb] = __builtin_amdgcn_mfma_f32_16x16x32_bf16(p, qq, acc[rb], 0, 0, 0);
        }
    }
}
__device__ __forceinline__ void unpack8(const u32x4 raw, float (&x)[8]) { x[0] = bflo(raw.x); x[1] = bfhi(raw.x); x[2] = bflo(raw.y); x[3] = bfhi(raw.y); x[4] = bflo(raw.z); x[5] = bfhi(raw.z); x[6] = bflo(raw.w); x[7] = bfhi(raw.w); }
__device__ __forceinline__ void gmlp_unit(const Ctx& C, int unit, bf16_t* ZA, const float* ln_g, const float* ln_b, const float* w_s, const float* b_s) {
    const int g = unit & 3, bc = unit >> 2; const size_t row0 = (size_t)bc * 128;
    float* stats = (float*)C.lds;
    bf16_t* vnT = (bf16_t*)(C.lds + 1024);
    bf16_t* wsL = (bf16_t*)(C.lds + 1024 + 128 * LP * 2);
    float* part = (float*)(C.lds + 1024 + 2 * 128 * LP * 2);
    const int w = C.wave, lane = C.lane, r = lane & 15, q = lane >> 4;
    u32x4 raw[2][8], fv[2][2]; u32x2 uw[8]; float bs[8];
#pragma unroll
    for (int h = 0; h < 2; ++h) { const int s = lane + 64 * h; const u32x4* vp = (const u32x4*)(ZA + (row0 + s) * 1024 + 512 + 64 * w);
#pragma unroll
        for (int k = 0; k < 8; ++k) raw[h][k] = vp[k];
        const u32x4* fp = (const u32x4*)(ZA + (row0 + s) * 1024 + 512 + g * 128 + 16 * w); fv[h][0] = fp[0]; fv[h][1] = fp[1]; }
#pragma unroll
    for (int tb = 0; tb < 8; ++tb) { const int t = 16 * tb + r; bs[tb] = b_s[g * 128 + t]; uw[tb] = *(const u32x2*)(ZA + (row0 + t) * 1024 + g * 128 + 16 * w + 4 * q); }
#pragma unroll
    for (int h = 0; h < 2; ++h) { const int s = lane + 64 * h;
        float s1 = 0.f, s2 = 0.f;
#pragma unroll
        for (int k = 0; k < 8; ++k) { float x[8]; unpack8(raw[h][k], x);
#pragma unroll
            for (int e = 0; e < 8; ++e) { s1 += x[e]; s2 += x[e] * x[e]; } }
        *(f32x2*)(part + (w * 128 + s) * 2) = (f32x2){s1, s2}; }
#pragma unroll
    for (int j = 0; j < 8; ++j) { const int idx = C.tid * 4 + 2048 * j, t = idx >> 7, s = idx & 127; const f32x4 v = *(const f32x4*)(w_s + (size_t)g * 128 * 128 + idx);
        u32x2 o; o.x = pk2(s <= t ? v[0] : 0.f, s + 1 <= t ? v[1] : 0.f); o.y = pk2(s + 2 <= t ? v[2] : 0.f, s + 3 <= t ? v[3] : 0.f);
        *(u32x2*)(wsL + t * LP + s) = o; }
    __syncthreads();
    if (C.tid < 128) { float s1 = 0.f, s2 = 0.f;
#pragma unroll
        for (int k = 0; k < 8; ++k) { const f32x2 p = *(const f32x2*)(part + (k * 128 + C.tid) * 2); s1 += p[0]; s2 += p[1]; }
        const float mean = s1 * (1.f / 512.f), var = fmaxf(s2 * (1.f / 512.f) - mean * mean, 0.f);
        *(f32x2*)(stats + 2 * C.tid) = (f32x2){mean, 1.0f / sqrtf(var + EPS)}; }
    __syncthreads();
    f32x4 gm[4], bt[4];
#pragma unroll
    for (int k = 0; k < 4; ++k) { gm[k] = *(const f32x4*)(ln_g + g * 128 + 16 * w + 4 * k); bt[k] = *(const f32x4*)(ln_b + g * 128 + 16 * w + 4 * k); }
#pragma unroll
    for (int h = 0; h < 2; ++h) { const int s = lane + 64 * h; const f32x2 st = *(const f32x2*)(stats + 2 * s);
        float x[16]; { float a[8], b[8]; unpack8(fv[h][0], a); unpack8(fv[h][1], b);
#pragma unroll
            for (int e = 0; e < 8; ++e) { x[e] = a[e]; x[8 + e] = b[e]; } }
#pragma unroll
        for (int j = 0; j < 16; ++j) vnT[(16 * w + j) * LP + s] = (bf16_t)f2bf((x[j] - st[0]) * st[1] * gm[j >> 2][j & 3] + bt[j >> 2][j & 3]); }
    __syncthreads();
    f32x4 acc[8];
    mm128<true>(vnT, wsL, w, r, q, acc);
#pragma unroll
    for (int tb = 0; tb < 8; ++tb) { const int t = 16 * tb + r;
        u32x2 o; o.x = pk2(bflo(uw[tb].x) * (acc[tb][0] + bs[tb]), bfhi(uw[tb].x) * (acc[tb][1] + bs[tb])); o.y = pk2(bflo(uw[tb].y) * (acc[tb][2] + bs[tb]), bfhi(uw[tb].y) * (acc[tb][3] + bs[tb]));
        *(u32x2*)(ZA + (row0 + t) * 1024 + g * 128 + 16 * w + 4 * q) = o; }
    __syncthreads();
}
template <int W>
__device__ __forceinline__ void pool_fill(const bf16_t* ZCg, int row0, int tid, bf16_t* pl) {
    const int c8 = tid & 15, s0 = 4 * (tid >> 4); const int rowb = row0 + s0, t0 = rowb & (SEQ - 1);
    u32x4 raw[W + 3];
#pragma unroll
    for (int k = 0; k < W + 3; ++k) { const int dt = k - (W - 1);
        raw[k] = (t0 + dt >= 0) ? *(const u32x4*)(ZCg + (size_t)(rowb + dt) * 512 + 8 * c8) : (u32x4){0u, 0u, 0u, 0u}; }
    float sum[8] = {0.f, 0.f, 0.f, 0.f, 0.f, 0.f, 0.f, 0.f};
#pragma unroll
    for (int k = 0; k < W; ++k) { float x[8]; unpack8(raw[k], x);
#pragma unroll
        for (int e = 0; e < 8; ++e) sum[e] += x[e]; }
#pragma unroll
    for (int j = 0; j < 4; ++j) { float self[8]; unpack8(raw[j + W - 1], self);
        if (j > 0) { float old[8]; unpack8(raw[j - 1], old);
#pragma unroll
            for (int e = 0; e < 8; ++e) sum[e] += self[e] - old[e]; }
        const int cnt = (t0 + j + 1 < W) ? t0 + j + 1 : W; const float inv = 1.0f / (float)cnt;
        u32x4 o; o.x = pk2(sum[0] * inv - self[0], sum[1] * inv - self[1]); o.y = pk2(sum[2] * inv - self[2], sum[3] * inv - self[3]);
        o.z = pk2(sum[4] * inv - self[4], sum[5] * inv - self[5]); o.w = pk2(sum[6] * inv - self[6], sum[7] * inv - self[7]);
        *(u32x4*)(pl + (s0 + j) * LP + 8 * c8) = o; }
}
__device__ __forceinline__ void pool_unit(const Ctx& C, int unit, const bf16_t* ZC, const bf16_t* WpT, const float* pool_scale, bf16_t* YC) {
    const int g = unit & 3, tile = unit >> 2; const int row0 = tile * 128;
    bf16_t* pl = (bf16_t*)(C.lds + 1024);
    bf16_t* wl = (bf16_t*)(C.lds + 1024 + 128 * LP * 2);
    const int w = C.wave, lane = C.lane;
    if (g == 0) pool_fill<2>(ZC + g * 128, row0, C.tid, pl); else if (g == 1) pool_fill<4>(ZC + g * 128, row0, C.tid, pl);
    else if (g == 2) pool_fill<8>(ZC + g * 128, row0, C.tid, pl); else pool_fill<16>(ZC + g * 128, row0, C.tid, pl);
#pragma unroll
    for (int j = 0; j < 4; ++j) { const int idx = C.tid + 512 * j, d = idx >> 4, c16 = idx & 15;
        *(u32x4*)(wl + d * LP + 8 * c16) = *(const u32x4*)(WpT + (size_t)g * 128 * 128 + d * 128 + 8 * c16); }
    __syncthreads();
    const int r = lane & 15, q = lane >> 4;
    f32x4 acc[8];
    mm128<false>(wl, pl, w, r, q, acc);
    const f32x4 ps = *(const f32x4*)(pool_scale + g * 128 + 16 * w + 4 * q);
#pragma unroll
    for (int sb = 0; sb < 8; ++sb) { const int s = 16 * sb + r;
        u32x2 o; o.x = pk2(acc[sb][0] * ps[0], acc[sb][1] * ps[1]); o.y = pk2(acc[sb][2] * ps[2], acc[sb][3] * ps[3]);
        *(u32x2*)(YC + (size_t)(row0 + s) * 1024 + 512 + g * 128 + 16 * w + 4 * q) = o; }
    __syncthreads();
}
namespace attn_body {
using bf16=unsigned short;
using s16x4=__attribute__((ext_vector_type(4)))short;
using f32x16=__attribute__((ext_vector_type(16)))float;
constexpr int BATCH=8,SEQ=2048,D=64,DM=1536;
constexpr int NW=8,QBLK=32,QB=QBLK*NW,KVBLK=64,NQB=SEQ/QB;
__device__ __forceinline__ int crow(int r,int hi){return (r&3)+8*(r>>2)+4*hi;}
#define SBAR() __builtin_amdgcn_sched_barrier(0)
__device__ __forceinline__ void cmask(f32x16&p0,f32x16&p1,int jb,int qrel,int hi){
  const float NEG=-INFINITY; int kb=64*jb+4*hi;
  #pragma unroll
  for(int r=0;r<16;++r){int kv=kb+(r&3)+8*(r>>2); if(kv>qrel)p0[r]=NEG; if(kv+32>qrel)p1[r]=NEG;}
}

constexpr int NSLOT=3, SLOTB=8192;
constexpr int LDS_K=0, LDS_V=NSLOT*SLOTB, LDS_WS=2*NSLOT*SLOTB, LDS_OST=LDS_WS+NW*64*4, LDS_BYTES=LDS_OST+NW*8192;
constexpr float C2=0.125f*1.4426950408889634f;
__device__ __forceinline__ void glds16(const void*gsrc,unsigned lds_dst){unsigned keep;
  asm volatile("s_mov_b32 %0, m0\n\ts_mov_b32 m0, %2\n\ts_nop 0\n\tglobal_load_lds_dwordx4 %1, off\n\ts_mov_b32 m0, %0":"=&s"(keep):"v"(gsrc),"s"(lds_dst):"memory");}
__device__ __forceinline__ float max3f(float a,float b,float c){float r;asm("v_max3_f32 %0, %1, %2, %3":"=v"(r):"v"(a),"v"(b),"v"(c));return r;}
__device__ __forceinline__ float max2f(float a,float b){float r;asm("v_max_f32_e32 %0, %1, %2":"=v"(r):"v"(a),"v"(b));return r;}
__device__ __forceinline__ float fadd_s(float a,float b){float r;asm("v_add_f32_e32 %0, %1, %2":"=v"(r):"v"(a),"v"(b));return r;}
__device__ __forceinline__ float fsub_s(float a,float b){float r;asm("v_sub_f32_e32 %0, %1, %2":"=v"(r):"v"(a),"v"(b));return r;}
typedef float f32x2_t __attribute__((ext_vector_type(2))); typedef __bf16 bf16x2_t __attribute__((ext_vector_type(2)));
__device__ __forceinline__ unsigned cvtpk_s(float lo,float hi){f32x2_t v={lo,hi};bf16x2_t b=__builtin_convertvector(v,bf16x2_t);return __builtin_bit_cast(unsigned,b);}
#define WAIT_BAR(N) asm volatile("s_waitcnt vmcnt(" #N ") lgkmcnt(0)\n\ts_barrier":::"memory")

__device__ __forceinline__ void qkt(f32x16&p0,f32x16&p1,const char*Kslot,const bf16x8*qr,const f32x16&negm,int r32,int hi){
  const char*kb=Kslot+hi*1024+r32*16;
  #pragma unroll
  for(int d0=0;d0<4;++d0){
    const bf16x8 b0=*reinterpret_cast<const bf16x8*>(kb+d0*2048);
    const bf16x8 b1=*reinterpret_cast<const bf16x8*>(kb+d0*2048+512);
    if(d0==0){p0=__builtin_amdgcn_mfma_f32_32x32x16_bf16(b0,qr[0],negm,0,0,0);p1=__builtin_amdgcn_mfma_f32_32x32x16_bf16(b1,qr[0],negm,0,0,0);}
    else{p0=__builtin_amdgcn_mfma_f32_32x32x16_bf16(b0,qr[d0],p0,0,0,0);p1=__builtin_amdgcn_mfma_f32_32x32x16_bf16(b1,qr[d0],p1,0,0,0);}}
}
typedef __attribute__((address_space(3))) const char* lds_cptr;
typedef short v4i16_t __attribute__((ext_vector_type(4)));
__device__ __forceinline__ void kload8(bf16x8*kf,lds_cptr kp){
  kf[0]=*(const __attribute__((address_space(3))) bf16x8*)(kp);      kf[1]=*(const __attribute__((address_space(3))) bf16x8*)(kp+512);
  kf[2]=*(const __attribute__((address_space(3))) bf16x8*)(kp+2048); kf[3]=*(const __attribute__((address_space(3))) bf16x8*)(kp+2560);
  kf[4]=*(const __attribute__((address_space(3))) bf16x8*)(kp+4096); kf[5]=*(const __attribute__((address_space(3))) bf16x8*)(kp+4608);
  kf[6]=*(const __attribute__((address_space(3))) bf16x8*)(kp+6144); kf[7]=*(const __attribute__((address_space(3))) bf16x8*)(kp+6656);
}
__device__ __forceinline__ void kload2(bf16x8*kf,lds_cptr kp,int j){ kf[2*j]=*(const __attribute__((address_space(3))) bf16x8*)(kp+j*2048); kf[2*j+1]=*(const __attribute__((address_space(3))) bf16x8*)(kp+j*2048+512); }
__device__ __forceinline__ s16x4 vtr(lds_cptr p){ return __builtin_bit_cast(s16x4,__builtin_amdgcn_ds_read_tr16_b64_v4i16((__attribute__((address_space(3))) v4i16_t*)p)); }
__device__ __forceinline__ float rowmax(const f32x16&p0,const f32x16&p1){
  float a=max3f(p0[0],p0[1],p1[0]),b=max3f(p0[2],p0[3],p1[1]);a=max3f(a,p1[2],p1[3]);
  #pragma unroll
  for(int r=4;r<16;r+=4){a=max3f(a,p0[r],p0[r+1]);b=max3f(b,p0[r+2],p0[r+3]);a=max3f(a,p1[r],p1[r+1]);b=max3f(b,p1[r+2],p1[r+3]);}
  const float m=max2f(a,b);
  auto rr=__builtin_amdgcn_permlane32_swap(__float_as_uint(m),__float_as_uint(m),false,false);
  return max2f(__uint_as_float(rr[0]),__uint_as_float(rr[1]));
}
__device__ __forceinline__ void pv(f32x16*o,int vb,bf16x8 pa0,bf16x8 pa1,bf16x8 pa2,bf16x8 pa3){
  #pragma unroll
  for(int d0=0;d0<2;++d0){s16x4 lo[4],hi[4];
    #pragma unroll
    for(int ks=0;ks<4;++ks){
      asm volatile("ds_read_b64_tr_b16 %0,%1 offset:%c2":"=&v"(lo[ks]):"v"(vb),"i"(d0*4096+ks*1024):"memory");
      asm volatile("ds_read_b64_tr_b16 %0,%1 offset:%c2":"=&v"(hi[ks]):"v"(vb),"i"(d0*4096+ks*1024+512):"memory");}
    asm volatile("s_waitcnt lgkmcnt(0)":::"memory");SBAR();
    #define PK(k) (bf16x8){lo[k][0],lo[k][1],lo[k][2],lo[k][3],hi[k][0],hi[k][1],hi[k][2],hi[k][3]}
    o[d0]=__builtin_amdgcn_mfma_f32_32x32x16_bf16(pa0,PK(0),o[d0],0,0,0);
    o[d0]=__builtin_amdgcn_mfma_f32_32x32x16_bf16(pa1,PK(1),o[d0],0,0,0);
    o[d0]=__builtin_amdgcn_mfma_f32_32x32x16_bf16(pa2,PK(2),o[d0],0,0,0);
    o[d0]=__builtin_amdgcn_mfma_f32_32x32x16_bf16(pa3,PK(3),o[d0],0,0,0);
    #undef PK
  }
}

#ifndef ATTN_STORE16
#define ATTN_STORE16(p,v) (*(u32x4*)(p)=(v))
#endif
template<int THRL> __device__ __forceinline__ void attn_unit(int b,int qb,const bf16*Q,const bf16*__restrict__ K,const bf16*__restrict__ V,int c,int vh,float lam,char*shm,int wave_){
  const int tid=fresh_tid(wave_),lane=tid&63,r32=lane&31,hi=lane>>5; const int wid=__builtin_amdgcn_readfirstlane(tid>>6);
  const long rowbase=(long)b*SEQ; const int q0=qb*QB;
  const bf16*Qw=Q+(rowbase+q0+wid*QBLK)*DM;
  const bf16*Kh=K+rowbase*DM,*Vh=V+rowbase*DM;
  const unsigned lds0=(unsigned)(uintptr_t)shm;
  float*wsf=(float*)(shm+LDS_WS)+wid*64;
  const bf16*ksrc=Kh+(long)lane*DM+wid*8;
  const bf16*vsrc=Vh+(long)(16*(wid&3)+(lane>>2))*DM+(wid>>2)*32+(lane&3)*8;
  const unsigned kdst=lds0+LDS_K+wid*1024, vdst=lds0+LDS_V+wid*1024;
  #define DMA_K(t,slot) glds16(ksrc+(long)(t)*KVBLK*DM,(unsigned)__builtin_amdgcn_readfirstlane(kdst+(slot)))
  #define DMA_V(t,slot) glds16(vsrc+(long)(t)*KVBLK*DM,(unsigned)__builtin_amdgcn_readfirstlane(vdst+(slot)))
  const int vb0=(int)(lds0+LDS_V)+((lane>>4)&1)*32+(lane&3)*8+(4*hi+((lane&15)>>2))*64;
  const char*Kbase=shm+LDS_K; bf16x8 kf[8];
  const lds_cptr shm3=(lds_cptr)shm; const lds_cptr kp0=shm3+LDS_K+hi*1024+r32*16; const lds_cptr vp0=shm3+LDS_V+((lane>>4)&1)*32+(lane&3)*8+(4*hi+((lane&15)>>2))*64;
  const int NT=(q0+QB)/KVBLK;
  DMA_K(0,0);DMA_V(0,0);DMA_K(1,SLOTB);
  bf16x8 qr[4];
  #pragma unroll
  for(int d0=0;d0<4;++d0)qr[d0]=*reinterpret_cast<const bf16x8*>(&Qw[(long)r32*DM+d0*16+hi*8]);
  float mhat=0.f,l_reg=0.f;f32x16 o[2];o[0]=f32x16{};o[1]=f32x16{};f32x16 negm=f32x16{};asm volatile("":"+v"(negm));
  const int qrel=wid*QBLK+r32;
  #define CMASK(P0,P1,t) do{int jb_=(t)-(NT-4); if(jb_>=0)cmask(P0,P1,jb_,qrel,hi);}while(0)
  bool resc=false;
  #define START(P0,P1) do{ const float rm=rowmax(P0,P1); resc=false; \
    { const float dl=rm; mhat=fadd_s(mhat,dl); \
      _Pragma("unroll") for(int r=0;r<16;++r){P0[r]=fsub_s(P0[r],dl);P1[r]=fsub_s(P1[r],dl);} \
      _Pragma("unroll") for(int r=0;r<16;++r)negm[r]=-mhat; asm volatile("":"+v"(negm)); } \
    _Pragma("unroll") for(int r=0;r<16;++r)P0[r]=__builtin_amdgcn_exp2f(P0[r]); }while(0)
  #define RESC() do{ if(resc){ asm volatile("s_waitcnt lgkmcnt(0)":::"memory"); \
      _Pragma("unroll") for(int d_=0;d_<2;++d_) _Pragma("unroll") for(int r=0;r<16;++r)o[d_][r]*=wsf[crow(r,hi)]; } }while(0)
  f32x16 pA0,pA1,pB0,pB1;
  int sl_prev=0,sl_cur=0,sl_next=SLOTB;
  #define ROT() do{sl_prev=sl_cur;sl_cur=sl_next;sl_next=(sl_next==(NSLOT-1)*SLOTB)?0:sl_next+SLOTB;}while(0)
  DMA_K(2,2*SLOTB);
  WAIT_BAR(3);
  qkt(pA0,pA1,Kbase,qr,negm,r32,hi);asm volatile("s_nop 15\n\ts_nop 7":"+v"(pA0),"+v"(pA1));CMASK(pA0,pA1,0);
  START(pA0,pA1);
  _Pragma("unroll") for(int r=0;r<16;++r)pA1[r]=__builtin_amdgcn_exp2f(pA1[r]);
  WAIT_BAR(0);
  DMA_K(3,0);DMA_V(1,SLOTB);
  ROT();
  kload8(kf,kp0+sl_cur);
  WAIT_BAR(2);
  s16x4 vlo[8],vhi[8]; u32x4 pw0,pw1,pw2,pw3;
  #define PKW(P,B) cvtpk_s(P[B],P[B+1])
  #define PAF(k) __builtin_bit_cast(bf16x8,pw##k)
  #define VFR(i) (bf16x8){vlo[i][0],vlo[i][1],vlo[i][2],vlo[i][3],vhi[i][0],vhi[i][1],vhi[i][2],vhi[i][3]}
  #define PIN(x) asm volatile("":"+v"(x))
  #define MX3(a,b,c) __builtin_fmaxf(__builtin_fmaxf((a),(b)),(c))
  #define GAPA(MF,A0,A1,A2,A3,W0,W1,PW) do{ MF; sacc+=A0; sacc+=A1; sacc+=A2; sacc+=A3; PIN(sacc); W0; W1; PIN(PW); SBAR(); }while(0)
  #define EX(v) __builtin_amdgcn_exp2f(v)
  #define GAPB(MF,X,B) do{ MF; X[B]=EX(X[B]); X[B+1]=EX(X[B+1]); X[B+2]=EX(X[B+2]); X[B+3]=EX(X[B+3]); PIN(X); SBAR(); }while(0)
  #define VRD(i) do{ vlo[i]=vtr(vp_+(((i)>>2)*4096+((i)&3)*1024)); vhi[i]=vtr(vp_+(((i)>>2)*4096+((i)&3)*1024+512)); }while(0)
  #define KRD(G,j) do{ if(G){ kload2(kf,kp0+sl_next,j); SBAR(); } }while(0)
  #define STEP(C0,C1,P0,P1,t,GK,GV,GL) do{ SBAR(); \
    const lds_cptr vp_=vp0+sl_prev; \
    VRD(0); SBAR(); float sacc=(P0[0]+P0[1]); \
    GAPA(C0=__builtin_amdgcn_mfma_f32_32x32x16_bf16(kf[0],qr[0],negm,0,0,0), P0[2],P0[3],P0[4],P0[5],     pw0[0]=PKW(P0,0), pw0[1]=PKW(P0,2), pw0); \
    VRD(4); SBAR(); GAPA(C1=__builtin_amdgcn_mfma_f32_32x32x16_bf16(kf[1],qr[0],negm,0,0,0), P0[6],P0[7],P0[8],P0[9],     pw0[2]=PKW(P0,4), pw0[3]=PKW(P0,6), pw0); \
    VRD(1); SBAR(); GAPA(C0=__builtin_amdgcn_mfma_f32_32x32x16_bf16(kf[2],qr[1],C0,0,0,0),   P0[10],P0[11],P0[12],P0[13], pw1[0]=PKW(P0,8), pw1[1]=PKW(P0,10), pw1); \
    VRD(5); SBAR(); GAPA(C1=__builtin_amdgcn_mfma_f32_32x32x16_bf16(kf[3],qr[1],C1,0,0,0),   P0[14],P0[15],P1[0],P1[1],   pw1[2]=PKW(P0,12),pw1[3]=PKW(P0,14), pw1); \
    VRD(2); SBAR(); GAPA(C0=__builtin_amdgcn_mfma_f32_32x32x16_bf16(kf[4],qr[2],C0,0,0,0),   P1[2],P1[3],P1[4],P1[5],     pw2[0]=PKW(P1,0), pw2[1]=PKW(P1,2), pw2); \
    VRD(6); SBAR(); GAPA(C1=__builtin_amdgcn_mfma_f32_32x32x16_bf16(kf[5],qr[2],C1,0,0,0),   P1[6],P1[7],P1[8],P1[9],     pw2[2]=PKW(P1,4), pw2[3]=PKW(P1,6), pw2); \
    VRD(3); SBAR(); GAPA(C0=__builtin_amdgcn_mfma_f32_32x32x16_bf16(kf[6],qr[3],C0,0,0,0),   P1[10],P1[11],P1[12],P1[13], pw3[0]=PKW(P1,8), pw3[1]=PKW(P1,10), pw3); \
    VRD(7); SBAR(); GAPA(C1=__builtin_amdgcn_mfma_f32_32x32x16_bf16(kf[7],qr[3],C1,0,0,0),   P1[14],P1[15],0.f,0.f,       pw3[2]=PKW(P1,12),pw3[3]=PKW(P1,14), pw3); \
    l_reg+=sacc; \
    if(GK){DMA_K((t)+3,sl_cur);} if(GV){DMA_V((t)+1,sl_next);} \
    CMASK(C0,C1,t); \
    { float a=MX3(C0[0],C0[1],C1[0]),b=MX3(C0[2],C0[3],C1[1]); a=MX3(a,C1[2],C1[3]); \
      _Pragma("unroll") for(int r=4;r<16;r+=4){a=MX3(a,C0[r],C0[r+1]);b=MX3(b,C0[r+2],C0[r+3]);a=MX3(a,C1[r],C1[r+1]);b=MX3(b,C1[r+2],C1[r+3]);} \
      float rm=__builtin_fmaxf(a,b); { auto rr=__builtin_amdgcn_permlane32_swap(__float_as_uint(rm),__float_as_uint(rm),false,false); rm=__builtin_fmaxf(__uint_as_float(rr[0]),__uint_as_float(rr[1])); } \
      resc=false; \
      if(__builtin_expect(__any(rm>(float)THRL),0)){ const float dl=__builtin_fmaxf(rm,0.f); mhat+=dl; \
        _Pragma("unroll") for(int r=0;r<16;++r){C0[r]-=dl;C1[r]-=dl;} \
        _Pragma("unroll") for(int r=0;r<16;++r)negm[r]=-mhat; asm volatile("":"+v"(negm)); \
        const float f=__builtin_amdgcn_exp2f(-dl); l_reg*=f; if(hi==0)wsf[r32]=f; resc=true; } } \
    SBAR(); \
    GAPB(o[0]=__builtin_amdgcn_mfma_f32_32x32x16_bf16(PAF(0),VFR(0),o[0],0,0,0), C0,0); \
    GAPB(o[1]=__builtin_amdgcn_mfma_f32_32x32x16_bf16(PAF(0),VFR(4),o[1],0,0,0), C0,4); \
    KRD(GL,0); GAPB(o[0]=__builtin_amdgcn_mfma_f32_32x32x16_bf16(PAF(1),VFR(1),o[0],0,0,0), C0,8); \
    KRD(GL,1); GAPB(o[1]=__builtin_amdgcn_mfma_f32_32x32x16_bf16(PAF(1),VFR(5),o[1],0,0,0), C0,12); \
    KRD(GL,2); GAPB(o[0]=__builtin_amdgcn_mfma_f32_32x32x16_bf16(PAF(2),VFR(2),o[0],0,0,0), C1,0); \
    KRD(GL,3); GAPB(o[1]=__builtin_amdgcn_mfma_f32_32x32x16_bf16(PAF(2),VFR(6),o[1],0,0,0), C1,4); \
    GAPB(o[0]=__builtin_amdgcn_mfma_f32_32x32x16_bf16(PAF(3),VFR(3),o[0],0,0,0), C1,8); \
    GAPB(o[1]=__builtin_amdgcn_mfma_f32_32x32x16_bf16(PAF(3),VFR(7),o[1],0,0,0), C1,12); \
    }while(0)
  int t=1;
  #undef CMASK
  #define CMASK(P0,P1,t) do{}while(0)
  for(;t+5<NT;t+=2){
    STEP(pB0,pB1,pA0,pA1,t,true,true,true);     WAIT_BAR(2); RESC(); ROT();
    STEP(pA0,pA1,pB0,pB1,t+1,true,true,true);   WAIT_BAR(2); RESC(); ROT();
  }
  #undef CMASK
  #define CMASK(P0,P1,t) do{int jb_=(t)-(NT-4); if(jb_>=0)cmask(P0,P1,jb_,qrel,hi);}while(0)
  #define ENDW(tt) do{ if((tt)+3<NT){WAIT_BAR(2);} else if((tt)+2<NT){WAIT_BAR(1);} else {WAIT_BAR(0);} }while(0)
  for(;t+1<NT;t+=2){
    STEP(pB0,pB1,pA0,pA1,t,(t+3<NT),(t+1<NT),(t+1<NT));       ENDW(t);   RESC(); ROT();
    STEP(pA0,pA1,pB0,pB1,t+1,(t+4<NT),(t+2<NT),(t+2<NT));     ENDW(t+1); RESC(); ROT();
  }
  STEP(pB0,pB1,pA0,pA1,NT-1,false,false,false); RESC();
  { float sacc=pB0[0]+pB0[1]; _Pragma("unroll") for(int r=2;r<16;++r)sacc+=pB0[r]; _Pragma("unroll") for(int r=0;r<16;++r)sacc+=pB1[r]; l_reg+=sacc;
    pw0=(u32x4){PKW(pB0,0),PKW(pB0,2),PKW(pB0,4),PKW(pB0,6)};pw1=(u32x4){PKW(pB0,8),PKW(pB0,10),PKW(pB0,12),PKW(pB0,14)};pw2=(u32x4){PKW(pB1,0),PKW(pB1,2),PKW(pB1,4),PKW(pB1,6)};pw3=(u32x4){PKW(pB1,8),PKW(pB1,10),PKW(pB1,12),PKW(pB1,14)};
    SBAR(); pv(o,vb0+sl_cur,PAF(0),PAF(1),PAF(2),PAF(3)); }
  #undef PKW
  #undef PAF
  #undef VFR
  #undef PIN
  #undef MX3
  #undef GAPA
  #undef GAPB
  #undef EX
  #undef VRD
  #undef KRD
  #undef STEP
  #undef ENDW
  {auto rr=__builtin_amdgcn_permlane32_swap(__float_as_uint(l_reg),__float_as_uint(l_reg),false,false);l_reg=__uint_as_float(rr[0])+__uint_as_float(rr[1]);}
  if(hi==0)wsf[32+r32]=l_reg;asm volatile("s_waitcnt lgkmcnt(0)":::"memory");
  float rli[16];
  #pragma unroll
  for(int r=0;r<16;++r)rli[r]=__builtin_amdgcn_rcpf(wsf[32+crow(r,hi)]);
  { bf16*stg=(bf16*)(shm+LDS_OST)+wid*4096;
    if(c==0){
      #pragma unroll
      for(int r=0;r<16;++r){const int orow=crow(r,hi);
        #pragma unroll
        for(int d0=0;d0<2;++d0)stg[orow*128+vh*64+d0*32+r32]=(bf16)f2bf(o[d0][r]*rli[r]);}
    } else {
      #pragma unroll
      for(int r=0;r<16;++r){const int orow=crow(r,hi);
        #pragma unroll
        for(int d0=0;d0<2;++d0){bf16*p=stg+orow*128+vh*64+d0*32+r32; const float prev=__uint_as_float(((unsigned)*p)<<16); *p=(bf16)f2bf(prev-lam*(o[d0][r]*rli[r]));}}
    } }
  asm volatile("s_waitcnt lgkmcnt(0)\n\ts_barrier":::"memory");
  #undef DMA_K
  #undef DMA_V
  #undef CMASK
  #undef START
  #undef RESC
  #undef ROT
}
__device__ __forceinline__ void attn_finish(int b,int h,int qb,bf16*YB,const float*g,float out_scale,char*shm,int wave_){
  const int tid_=fresh_tid(wave_); const int lane=tid_&63; const int wid=__builtin_amdgcn_readfirstlane(tid_>>6);
  asm volatile("s_waitcnt lgkmcnt(0)":::"memory");
  const bf16*stg=(const bf16*)(shm+LDS_OST)+wid*4096; const int ch=lane&15;
  const f32x4 g0=*(const f32x4*)(g+ch*8),g1=*(const f32x4*)(g+ch*8+4);
  const size_t rowb=(size_t)b*SEQ+(size_t)qb*QB+wid*QBLK;
  #pragma unroll
  for(int i=0;i<8;++i){const int row=i*4+(lane>>4);
    const u32x4 v=*(const u32x4*)(stg+row*128+ch*8);
    const float x0=bflo(v.x),x1=bfhi(v.x),x2=bflo(v.y),x3=bfhi(v.y),x4=bflo(v.z),x5=bfhi(v.z),x6=bflo(v.w),x7=bfhi(v.w);
    float ss=(x0*x0+x1*x1)+(x2*x2+x3*x3)+(x4*x4+x5*x5)+(x6*x6+x7*x7);
    ss+=__shfl_xor(ss,1);ss+=__shfl_xor(ss,2);ss+=__shfl_xor(ss,4);ss+=__shfl_xor(ss,8);
    const float rs=out_scale/sqrtf(ss*(1.f/128.f)+EPS);
    u32x4 o;o.x=pk2(x0*rs*g0[0],x1*rs*g0[1]);o.y=pk2(x2*rs*g0[2],x3*rs*g0[3]);o.z=pk2(x4*rs*g1[0],x5*rs*g1[1]);o.w=pk2(x6*rs*g1[2],x7*rs*g1[3]);
    *(u32x4*)(YB+(rowb+row)*1024+h*128+ch*8)=o;}
  asm volatile("s_waitcnt lgkmcnt(0)":::"memory");
}
__device__ __forceinline__ void attn_finish_half(int b,int h,int qb,int vh,bf16*YB,const float*g,float out_scale,unsigned long long*xh,char*shm,int wave_){
  const int tid_=fresh_tid(wave_); const int lane=tid_&63; const int wid=__builtin_amdgcn_readfirstlane(tid_>>6);
  asm volatile("s_waitcnt lgkmcnt(0)":::"memory");
  const bf16*stg=(const bf16*)(shm+LDS_OST)+wid*4096; const int ch=lane&7;
  float x[4][8],ss[4];
  #pragma unroll
  for(int i=0;i<4;++i){const int row=i*8+(lane>>3);
    unpack8(*(const u32x4*)(stg+row*128+vh*64+ch*8),x[i]);
    float q=0.f;
    #pragma unroll
    for(int e=0;e<8;++e)q+=x[i][e]*x[i][e];
    q+=__shfl_xor(q,1);q+=__shfl_xor(q,2);q+=__shfl_xor(q,4);ss[i]=q;
    if(ch==0)__hip_atomic_store(xh+vh*256+wid*32+row,(1ull<<32)|(unsigned long long)__float_as_uint(q),__ATOMIC_RELAXED,__HIP_MEMORY_SCOPE_AGENT);}
  const f32x4 g0=*(const f32x4*)(g+vh*64+ch*8),g1=*(const f32x4*)(g+vh*64+ch*8+4);
  const size_t rowb=(size_t)b*SEQ+(size_t)qb*QB+wid*QBLK;
  #pragma unroll
  for(int i=0;i<4;++i){const int row=i*8+(lane>>3);
    unsigned long long pv=0ull;
    #pragma unroll 1
    for(unsigned it=0;it<(1u<<20);++it){pv=__hip_atomic_load(xh+(vh^1)*256+wid*32+row,__ATOMIC_RELAXED,__HIP_MEMORY_SCOPE_AGENT); if((pv>>32)!=0ull)break; __builtin_amdgcn_s_sleep(1);}
    const float tot=ss[i]+__uint_as_float((unsigned)pv);
    const float rs=out_scale/sqrtf(tot*(1.f/128.f)+EPS);
    u32x4 o;o.x=pk2(x[i][0]*rs*g0[0],x[i][1]*rs*g0[1]);o.y=pk2(x[i][2]*rs*g0[2],x[i][3]*rs*g0[3]);o.z=pk2(x[i][4]*rs*g1[0],x[i][5]*rs*g1[1]);o.w=pk2(x[i][6]*rs*g1[2],x[i][7]*rs*g1[3]);
    *(u32x4*)(YB+(rowb+row)*1024+h*128+vh*64+ch*8)=o;}
  asm volatile("s_waitcnt lgkmcnt(0)":::"memory");
}
constexpr int ATTN_LDS_BYTES=LDS_BYTES;
#undef SBAR
#undef WAIT_BAR
}

#define LAS __attribute__((address_space(3)))
constexpr size_t WS_CTL = 242 * MiB, CTL_ZERO_BYTES = 32768;
constexpr int LDSCTL_OFF = 131072, MISC_OFF = LDSCTL_OFF + 320;
#define XB_TMO      128
#define XB_XCNT(j)  (256  + 64 * (j))
#define XB_XSUB(j)  (1280 + 64 * (j))
#define XB_XGEN(j)  (2304 + 64 * (j))
#define XB_TOP      3328
#define XB_TOPGEN   3392
#define XCD_BAR_WORDS 3456
#define XB_SPIN_CAP (1u << 18)

__device__ __forceinline__ unsigned xb_ld(unsigned* p)              { return __hip_atomic_load(p, __ATOMIC_RELAXED, __HIP_MEMORY_SCOPE_AGENT); }
__device__ __forceinline__ unsigned xb_add(unsigned* p, unsigned v) { return __hip_atomic_fetch_add(p, v, __ATOMIC_RELAXED, __HIP_MEMORY_SCOPE_AGENT); }
__device__ __forceinline__ unsigned xb_xcc_id() { return (unsigned)__builtin_amdgcn_s_getreg((3 << 11) | 20) & 0xFu; }
#define XB_SPIN(cond, bar) do { unsigned _sp = 0; while (cond) { __builtin_amdgcn_s_sleep(1); \
    if ((++_sp & 255u) == 0u) { if (xb_ld(&(bar)[XB_TMO])) break; if (_sp > XB_SPIN_CAP) { atomicAdd(&(bar)[XB_TMO], 1u); break; } } } } while (0)

struct XcdBarrier {
    unsigned* bar; unsigned x;
    volatile LAS unsigned* st;
};

__device__ __forceinline__ XcdBarrier xcd_barrier_post(unsigned* bar, volatile LAS unsigned* st) {
    XcdBarrier b; b.bar = bar; b.x = xb_xcc_id(); b.st = st;
    if (threadIdx.x == 0) { st[3] = xb_add(&bar[XB_XCNT(b.x)], 1u); st[2] = blockIdx.x; }
    return b;
}
__device__ __forceinline__ void xcd_barrier_complete(unsigned* bar, unsigned x, unsigned& nloc, unsigned& nx) {
    const unsigned G = gridDim.x * gridDim.y * gridDim.z;
    unsigned sum, cnt, mine, sp = 0u;
    for (;;) {
        sum = 0u; cnt = 0u; mine = 0u;
#pragma unroll
        for (unsigned j = 0; j < 16; ++j) { const unsigned c = xb_ld(&bar[XB_XCNT(j)]); sum += c; cnt += (c > 0u) ? 1u : 0u; mine = (j == x) ? c : mine; }
        if (sum == G) break;
        __builtin_amdgcn_s_sleep(1);
        if ((++sp & 255u) == 0u) { if (xb_ld(&bar[XB_TMO])) break; if (sp > XB_SPIN_CAP) { atomicAdd(&bar[XB_TMO], 1u); break; } }
    }
    nloc = mine > 0u ? mine : 1u; nx = cnt > 0u ? cnt : 1u;
}

__device__ __forceinline__ void xcd_barrier(const XcdBarrier& b, bool thread0) {
    asm volatile("s_waitcnt vmcnt(0)" ::: "memory");
    __syncthreads();
    if (thread0) {
        unsigned* bar = b.bar;
        __builtin_amdgcn_s_waitcnt(0);
        unsigned nloc = b.st[0], nx = b.st[1];
        if (nloc == 0u) { xcd_barrier_complete(bar, b.x, nloc, nx); b.st[0] = nloc; b.st[1] = nx; }
        const unsigned old = xb_add(&bar[XB_XSUB(b.x)], 1u);
        const unsigned gen = old / nloc;
        if (old + 1u == (gen + 1u) * nloc) {
            __builtin_amdgcn_fence(__ATOMIC_RELEASE, "agent");
            asm volatile("s_waitcnt vmcnt(0)" ::: "memory");
            const unsigned og = xb_add(&bar[XB_TOP], 1u);
            const unsigned tg = og / nx;
            if (og + 1u == (tg + 1u) * nx) xb_add(&bar[XB_TOPGEN], 1u);
            else XB_SPIN(xb_ld(&bar[XB_TOPGEN]) == tg, bar);
            __builtin_amdgcn_fence(__ATOMIC_ACQUIRE, "agent");
            xb_add(&bar[XB_XGEN(b.x)], 1u);
            asm volatile("s_waitcnt vmcnt(0)" ::: "memory");
        } else {
            XB_SPIN(xb_ld(&bar[XB_XGEN(b.x)]) == gen, bar);
            __builtin_amdgcn_fence(__ATOMIC_ACQUIRE, "agent");
            asm volatile("s_waitcnt vmcnt(0)" ::: "memory");
        }
    }
    __syncthreads();
}

#define XB_XSUB2(j) (4096 + 64 * (j))
#define XB_XGEN2(j) (4608 + 64 * (j))
#define XB_TOP5 5248
#define XB_TOP6 5312
#define XB_TOP4 5184
#define XB_TOP3 5120
__device__ __forceinline__ void xcc_barrier(unsigned* bar, unsigned x, bool thread0, bool arrive_top, unsigned wait_top, int top_word) {
    asm volatile("s_waitcnt vmcnt(0)" ::: "memory");
    __syncthreads();
    if (thread0) {
        __builtin_amdgcn_s_waitcnt(0);
        const unsigned old = xb_add(&bar[XB_XSUB2(x)], 1u);
        const unsigned gen = old / 32u;
        if (old + 1u == (gen + 1u) * 32u) {
            __builtin_amdgcn_fence(__ATOMIC_RELEASE, "agent");
            asm volatile("s_waitcnt vmcnt(0)" ::: "memory");
            if (arrive_top) xb_add(&bar[top_word], 1u);
            if (wait_top != 0u) XB_SPIN(xb_ld(&bar[top_word]) < wait_top, bar);
            __builtin_amdgcn_fence(__ATOMIC_ACQUIRE, "agent");
            xb_add(&bar[XB_XGEN2(x)], 1u);
            asm volatile("s_waitcnt vmcnt(0)" ::: "memory");
        } else {
            XB_SPIN(xb_ld(&bar[XB_XGEN2(x)]) == gen, bar);
            __builtin_amdgcn_fence(__ATOMIC_ACQUIRE, "agent");
            asm volatile("s_waitcnt vmcnt(0)" ::: "memory");
        }
    }
    __syncthreads();
}

struct Args { const float* in[21]; float* out; unsigned char* ws; };
#define GRID_SYNC() do { XcdBarrier bar_; bar_.bar = (unsigned*)(ws + WS_CTL); bar_.x = xb_xcc_id(); bar_.st = (volatile LAS unsigned*)((LAS unsigned char*)lds + MISC_OFF) + 8; xcd_barrier(bar_, fresh_tid(my_wave) == 0); } while (0)
#define LOCAL_SYNC_EX(arrive_, wait_) LOCAL_SYNC_EX2(arrive_, wait_, XB_TOP3)
#define LOCAL_SYNC_EX2(arrive_, wait_, topw_) do { unsigned z_ = 0u; asm volatile("" : "+v"(z_)); LAS unsigned* fa_ = (LAS unsigned*)((LAS unsigned char*)lds + MISC_OFF + z_) + 12; \
        if (__builtin_amdgcn_readfirstlane(*(volatile LAS unsigned*)fa_) != 0u) xcc_barrier((unsigned*)(ws + WS_CTL), xb_xcc_id(), fresh_tid(my_wave) == 0, (arrive_), (wait_), (topw_)); else GRID_SYNC(); } while (0)
#define LOCAL_SYNC() LOCAL_SYNC_EX(false, 0u)

__global__ void __launch_bounds__(NTHR, 2) fwd_megakernel(Args args) {
    extern __shared__ __attribute__((aligned(16))) unsigned char lds[];
    cg::grid_group grid = cg::this_grid();
    const int my_wave = __builtin_amdgcn_readfirstlane(threadIdx.x >> 6);
    Ctx C;
    typedef const __attribute__((address_space(4))) unsigned long long* kargp_t;
    kargp_t kp;
#define FRESH_CTX() do { const int t_ = fresh_tid(my_wave); C.lds = lds; C.tid = t_; C.lane = t_ & 63; C.wave = __builtin_amdgcn_readfirstlane(t_ >> 6); \
        C.gw = blockIdx.x * NWAVES + C.wave; C.ngw = gridDim.x * NWAVES; kp = (kargp_t)__builtin_amdgcn_kernarg_segment_ptr(); asm volatile("" : "+s"(kp)); G = gridDim.x; { unsigned z_ = 0u; asm volatile("" : "+v"(z_)); LAS unsigned* ra_ = (LAS unsigned*)((LAS unsigned char*)lds + MISC_OFF + z_) + 10; bid = (int)__builtin_amdgcn_readfirstlane(*(volatile LAS unsigned*)ra_); } asm volatile("" : "+s"(G), "+s"(bid)); } while (0)
#define GASP __attribute__((address_space(1)))
#define IN(k) ((const float*)(const GASP float*)kp[k])
#define xout ((float*)(GASP float*)kp[21])
#define ws ((unsigned char*)(GASP unsigned char*)kp[22])
#define x_in IN(0)
#define ZA ((bf16_t*)(ws + WS_ZA))
#define QKV ((bf16_t*)(ws + WS_QKV))
#define ZC ((bf16_t*)(ws + WS_ZC))
#define GB ((bf16_t*)(ws + WS_G))
#define G8B ((unsigned char*)(ws + WS_G))
#define H8B ((G == 256) ? (unsigned char*)xout + 32 * MiB : (unsigned char*)(ws + WS_MG))
#define MGB ((bf16_t*)(ws + WS_MG))
#define HB ((bf16_t*)(ws + WS_H))
#define PB ((float*)(ws + WS_P))
    int G, bid;
    FRESH_CTX();
    for (int u = C.tid; u < (LDS_BYTES - LDSCTL_OFF) / 4; u += NTHR) ((LAS unsigned*)((LAS unsigned char*)lds + LDSCTL_OFF))[u] = 0u;
    __syncthreads();
    (void)xcd_barrier_post((unsigned*)(ws + WS_CTL), (volatile LAS unsigned*)((LAS unsigned char*)lds + MISC_OFF) + 8);
    __syncthreads();
    FRESH_CTX();
    if (G == 0x7fffffff) grid.sync();

    convert_mixer_weights(C, IN(2), IN(14), IN(15), IN(12), ws);
    for (int m = C.gw; m < MTOK; m += 4 * C.ngw) rms_rows4_to_bf16(x_in, IN(1), HB, H8B, m, C.ngw, C.lane);
    { u32x4* z = (u32x4*)(ws + WS_XH); const int nz = (int)((2 * MiB) / 16);
      for (int i = (bid * NTHR + C.tid); i < nz; i += G * NTHR) z[i] = (u32x4){0u, 0u, 0u, 0u};
      u32x4* z2 = (u32x4*)(ws + WS_XS); const int nz2 = (int)((8 * XS_BANK) / 16);
      for (int i = (bid * NTHR + C.tid); i < nz2; i += G * NTHR) z2[i] = (u32x4){0u, 0u, 0u, 0u}; }
    GRID_SYNC();
    if (fresh_tid(my_wave) == 0) {
        volatile LAS unsigned* misc = (volatile LAS unsigned*)((LAS unsigned char*)lds + MISC_OFF);
        unsigned* barw = (unsigned*)(ws + WS_CTL); bool ok = (gridDim.x == 256);
#pragma unroll
        for (int j = 0; j < 8; ++j) ok = ok && (xb_ld(&barw[XB_XCNT(j)]) == 32u);
        const unsigned xme = xb_xcc_id();
        if (ok && xme < 8u) { misc[10] = misc[11] * 8u + xme; misc[12] = 1u; }
    }
    __syncthreads();

#pragma unroll 1
    for (int l = 0; l < 2; ++l) {

        FRESH_CTX();
        { Gemm g{1024, 1024}; StaticOrder S; S.init(MTOK, 3072, G, bid, HB, 1024, (const bf16_t*)(ws + WS_WIN), 1024);
          EpiIn E{ZA, QKV, ZC};
          GEMM_PHASE(EpiIn, StaticOrder, g, S, E); }
        FRESH_CTX();
        { Gemm g{512, 512}; StaticOrder S; S.init(MTOK, 3072, G, bid, (const bf16_t*)H8B, 512, (const bf16_t*)(ws + WS_WG8), 512);
          EpiGate E{G8B};
          GEMM_PHASE(EpiGate, StaticOrder, g, S, E); }
        LOCAL_SYNC_EX2(true, 0u, XB_TOP5);
        FRESH_CTX();
        { const float linit = 0.8f - 0.6f * expf(-0.3f * (float)l);
          const float d1 = wave_sum(IN(7)[l * 64 + C.lane] * IN(8)[l * 64 + C.lane]), d2 = wave_sum(IN(9)[l * 64 + C.lane] * IN(10)[l * 64 + C.lane]);
          const float lam = expf(d1) - expf(d2) + linit;
          const int vcu = (G % 8 == 0) ? (bid % 8) * (G / 8) + bid / 8 : bid;
#define MIX_LIGHT(u_) do { const int uu_ = (u_); if (uu_ & 1) pool_unit(C, uu_ >> 1, ZC, (const bf16_t*)(ws + WS_WPOOL), IN(13) + l * 512, HB); \
              else gmlp_unit(C, uu_ >> 1, ZA, IN(3) + l * 512, IN(4) + l * 512, IN(5) + (size_t)l * 4 * 128 * 128, IN(6) + l * 512); } while (0)
          int njobs, jgrp, jq0, jq1, jvlo, jvhi, jstep, side_pos = -1;
          if (G == 256) {
              const int sx = vcu & 7, kx = sx & 3;
              side_pos = 1 + ((vcu >> 3) & 1);
              njobs = 2; jgrp = vcu >> 3; jq0 = 7 - kx; jq1 = kx; jvlo = jvhi = sx >> 2; jstep = 0;
          } else {
#pragma unroll 1
              for (int u = bid; u < 1024; u += G) MIX_LIGHT(u);
              njobs = (256 - bid + G - 1) / G; jgrp = 0; jq0 = 0; jq1 = 0; jvlo = 0; jvhi = 1; jstep = G;
          }
#define MIX_SIDE() do { { unsigned z_ = 0u; asm volatile("" : "+v"(z_)); LAS unsigned* fa_ = (LAS unsigned*)((LAS unsigned char*)lds + MISC_OFF + z_) + 12; \
              if (__builtin_amdgcn_readfirstlane(*(volatile LAS unsigned*)fa_) != 0u && fresh_tid(my_wave) == 0) { unsigned* barw_ = (unsigned*)(ws + WS_CTL); XB_SPIN(xb_ld(&barw_[XB_TOP5]) < 8u * (unsigned)(l + 1), barw_); } } \
              __syncthreads(); FRESH_CTX(); \
              convert_ffn_weights(C, IN(18) + (size_t)l * 1024 * 2 * DFF, IN(19) + (size_t)l * DFF * 1024, ws); __syncthreads(); \
              _Pragma("unroll 1") for (int jl_ = 0; jl_ < 4; ++jl_) MIX_LIGHT(((G % 8 == 0) ? (bid % 8) * (G / 8) + bid / 8 : bid) * 4 + jl_); } while (0)
#pragma unroll 1
          for (int j = 0; j <= njobs; ++j) {
              if (j == side_pos) MIX_SIDE();
              if (j == njobs) break;
              int grp_, qb_;
              if (jstep == 0) { grp_ = jgrp; qb_ = (j == 0) ? jq0 : jq1; } else { const int a = bid + j * jstep; grp_ = a >> 3; qb_ = a & 7; }
              const int b_ = grp_ >> 2, h_ = grp_ & 3;
#pragma unroll 1
              for (int p_ = 2 * jvlo; p_ < 2 * jvhi + 2; ++p_) { const int c_ = p_ & 1, vh_ = p_ >> 1;
                  attn_body::attn_unit<8>(b_, qb_, QKV + h_ * 128 + c_ * 64, QKV + 512 + h_ * 128 + c_ * 64, QKV + 1024 + h_ * 128 + vh_ * 64, c_, vh_, lam, (char*)lds, my_wave); }
              if (jvlo == jvhi) attn_body::attn_finish_half(b_, h_, qb_, jvlo, HB, IN(11) + l * 128, 1.0f - linit, (unsigned long long*)(ws + WS_XH) + ((size_t)(l * 32 + grp_) * 8 + qb_) * 512, (char*)lds, my_wave);
              else attn_body::attn_finish(b_, h_, qb_, HB, IN(11) + l * 128, 1.0f - linit, (char*)lds, my_wave);
          }
#undef MIX_SIDE
#undef MIX_LIGHT
        }
        LOCAL_SYNC_EX(true, 0u);
        FRESH_CTX();
        if (G != 256) convert_ffn_weights(C, IN(18) + (size_t)l * 1024 * 2 * DFF, IN(19) + (size_t)l * DFF * 1024, ws);
        __syncthreads();
        FRESH_CTX();
        { Gemm g{1024, 512}; BranchOrder S; S.so.init(MTOK, 1024, G, bid, nullptr, 1024, nullptr, 512);
          S.A0 = ZA; S.Bt = (const bf16_t*)(ws + WS_WB); S.bstride = (size_t)1024 * 512;
          EpiBranch E{G8B, MGB};
          GEMM_PHASE(EpiBranch, BranchOrder, g, S, E); }
        LOCAL_SYNC();
        if (G == 256) {
            FRESH_CTX();
            { Gemm g{1024, 1024}; StaticOrder S; S.init(MTOK, 1024, G, bid, MGB, 1024, (const bf16_t*)(ws + WS_WOUT), 1024);
              const PanelRms p1{(unsigned long long*)(ws + WS_XS + (size_t)(4 * l + 0) * XS_BANK)}, p2{(unsigned long long*)(ws + WS_XS + (size_t)(4 * l + 1) * XS_BANK)};
              if (l == 0) { EpiRmsRes<false> E{x_in, nullptr, ZA, IN(16) + l * DM, IN(17) + l * DM, HB, nullptr, p1, p2, nullptr, 0u}; GEMM_PHASE(EpiRmsRes<false>, StaticOrder, g, S, E); }
              else { EpiRmsRes<true> E{(const bf16_t*)xout, nullptr, ZA, IN(16) + l * DM, IN(17) + l * DM, HB, nullptr, p1, p2, nullptr, 0u}; GEMM_PHASE(EpiRmsRes<true>, StaticOrder, g, S, E); } }
            LOCAL_SYNC_EX(false, 8u * (unsigned)(l + 1));
        } else {
            FRESH_CTX();
            { Gemm g{1024, 1024}; StaticOrder S; S.init(MTOK, 1024, G, bid, MGB, 1024, (const bf16_t*)(ws + WS_WOUT), 1024);
              EpiF32 E{PB};
              GEMM_PHASE(EpiF32, StaticOrder, g, S, E); }
            GRID_SYNC();
            FRESH_CTX();
            for (int m = C.gw; m < MTOK; m += C.ngw)
                res_norm_row(PB + (size_t)m * DM, ((l == 0) ? x_in : (const float*)xout) + (size_t)m * DM, xout + (size_t)m * DM, IN(16) + l * DM, IN(17) + l * DM, HB + (size_t)m * DM, nullptr, C.lane);
            GRID_SYNC();
        }
        FRESH_CTX();
        { Gemm g{1024, 1024}; StaticOrder S; S.init(MTOK, 2 * DFF, G, bid, HB, 1024, (const bf16_t*)(ws + WS_WF1), 1024);
          EpiSwiglu E{GB};
          GEMM_PHASE(EpiSwiglu, StaticOrder, g, S, E); }
        if (l == 0) LOCAL_SYNC_EX2(true, 0u, XB_TOP4); else LOCAL_SYNC_EX2(true, 0u, XB_TOP6);
        FRESH_CTX();
        bool lm7; { unsigned z_ = 0u; asm volatile("" : "+v"(z_)); LAS unsigned* fa_ = (LAS unsigned*)((LAS unsigned char*)lds + MISC_OFF + z_) + 12; lm7 = __builtin_amdgcn_readfirstlane(*(volatile LAS unsigned*)fa_) != 0u; }
        if (l == 0 && !lm7) convert_mixer_weights(C, IN(2) + (size_t)1024 * IN_TOTAL, IN(14) + (size_t)3 * 512 * 1024, IN(15) + (size_t)1024 * 1024, IN(12) + (size_t)4 * 128 * 128, ws);
        __syncthreads();
        if (G == 256) {
            FRESH_CTX();
            { Gemm g{DFF, DFF}; StaticOrder S; S.init(MTOK, 1024, G, bid, GB, DFF, (const bf16_t*)(ws + WS_WF2), DFF);
              const PanelRms p1{(unsigned long long*)(ws + WS_XS + (size_t)(4 * l + 2) * XS_BANK)}, p2{(unsigned long long*)(ws + WS_XS + (size_t)(4 * l + 3) * XS_BANK)};
              bool lm9; { unsigned z_ = 0u; asm volatile("" : "+v"(z_)); LAS unsigned* fa_ = (LAS unsigned*)((LAS unsigned char*)lds + MISC_OFF + z_) + 12; lm9 = __builtin_amdgcn_readfirstlane(*(volatile LAS unsigned*)fa_) != 0u; }
              EpiRmsRes<true> E{ZA, (l == 0) ? nullptr : xout, (bf16_t*)xout, IN(20) + l * DM, (l == 0) ? IN(1) + DM : nullptr, HB, H8B, p1, p2, (l == 1 && lm9) ? (unsigned*)(ws + WS_CTL) + XB_TOP6 : nullptr, 8u};
              GEMM_PHASE(EpiRmsRes<true>, StaticOrder, g, S, E); }
        } else {
            FRESH_CTX();
            { Gemm g{DFF, DFF}; StaticOrder S; S.init(MTOK, 1024, G, bid, GB, DFF, (const bf16_t*)(ws + WS_WF2), DFF);
              EpiF32 E{PB};
              GEMM_PHASE(EpiF32, StaticOrder, g, S, E); }
            GRID_SYNC();
            FRESH_CTX();
            for (int m = C.gw; m < MTOK; m += C.ngw)
                res_norm_row(PB + (size_t)m * DM, xout + (size_t)m * DM, xout + (size_t)m * DM, IN(20) + l * DM, (l == 0) ? IN(1) + DM : nullptr, HB + (size_t)m * DM, H8B + (size_t)m * DM, C.lane);
        }
        if (l == 0) {
            FRESH_CTX();
            bool lm8; { unsigned z_ = 0u; asm volatile("" : "+v"(z_)); LAS unsigned* fa_ = (LAS unsigned*)((LAS unsigned char*)lds + MISC_OFF + z_) + 12; lm8 = __builtin_amdgcn_readfirstlane(*(volatile LAS unsigned*)fa_) != 0u; }
            if (lm8) {
                if (C.tid == 0) { unsigned* barw = (unsigned*)(ws + WS_CTL); XB_SPIN(xb_ld(&barw[XB_TOP4]) < 8u, barw); }
                __syncthreads();
                convert_mixer_weights(C, IN(2) + (size_t)1024 * IN_TOTAL, IN(14) + (size_t)3 * 512 * 1024, IN(15) + (size_t)1024 * 1024, IN(12) + (size_t)4 * 128 * 128, ws);
            }
            GRID_SYNC();
        }
    }
}

#undef IN
#undef xout
#undef ws
#undef x_in
#undef ZA
#undef QKV
#undef ZC
#undef GB
#undef G8B
#undef H8B
#undef MGB
#undef HB
#undef PB
extern "C" void kernel_launch(void* const* d_in, const int* in_sizes, int n_in, void* d_out, int out_size, void* d_ws, size_t ws_size, hipStream_t stream) {
    static int grid = 0;
    if (grid == 0) {
        if (n_in != 21 || out_size != MTOK * DM || ws_size < WS_END) { fprintf(stderr, "kernel_launch: unexpected problem (n_in %d out %d ws %zu)\n", n_in, out_size, ws_size); grid = -1; return; }
        int dev = 0, cus = 0, per_cu = 0;
        hipGetDevice(&dev); hipDeviceGetAttribute(&cus, hipDeviceAttributeMultiprocessorCount, dev);
        hipFuncSetAttribute((const void*)fwd_megakernel, hipFuncAttributeMaxDynamicSharedMemorySize, LDS_BYTES);
        hipOccupancyMaxActiveBlocksPerMultiprocessor(&per_cu, (const void*)fwd_megakernel, NTHR, LDS_BYTES);
        if (per_cu < 1) { fprintf(stderr, "kernel_launch: occupancy query says %d\n", per_cu); per_cu = 1; }
        (void)hipGetLastError();
        grid = cus * 1;
    }
    if (grid < 0) return;
    if (hipMemsetAsync((char*)d_ws + WS_CTL, 0, CTL_ZERO_BYTES, stream) != hipSuccess) { fprintf(stderr, "kernel_launch: memset of the barrier words failed\n"); return; }
    Args a{};
    for (int i = 0; i < 21; ++i) a.in[i] = (const float*)d_in[i];
    a.out = (float*)d_out; a.ws = (unsigned char*)d_ws;
    void* kargs[] = {&a};
    hipError_t e = hipLaunchCooperativeKernel((const void*)fwd_megakernel, dim3(grid), dim3(NTHR), kargs, LDS_BYTES, stream);
    if (e != hipSuccess) fprintf(stderr, "cooperative launch failed: %s (grid %d)\n", hipGetErrorString(e), grid);
}
```

```cpp
#include <hip/hip_runtime.h>
#include <hip/hip_cooperative_groups.h>
#include <cstdio>
#include <cstdint>
#include <cmath>
namespace cg = cooperative_groups;

typedef unsigned short bf16_t;
typedef short bf16x8 __attribute__((ext_vector_type(8)));
typedef float f32x4 __attribute__((ext_vector_type(4)));
typedef float f32x2 __attribute__((ext_vector_type(2)));
typedef unsigned u32x4 __attribute__((ext_vector_type(4)));
typedef unsigned u32x2 __attribute__((ext_vector_type(2)));
typedef int v4i_t __attribute__((ext_vector_type(4)));
typedef int v8i_t __attribute__((ext_vector_type(8)));

constexpr int NB = 8, SEQ = 2048, DM = 1024, MTOK = NB * SEQ;
constexpr int IN_TOTAL = 6144, DFF = 2816;
constexpr int NWAVES = 8, NTHR = 512;
constexpr float EPS = 1e-6f;
constexpr float C2 = 0.125f * 1.4426950408889634f;
constexpr int LDS_BYTES = 147456;

constexpr size_t MiB = 1u << 20;
constexpr size_t WS_W = 0;
constexpr size_t WS_WIN = 0, WS_WG8 = 6 * MiB, WS_WB = 12 * MiB, WS_WOUT = 15 * MiB, WS_WPOOL = 17 * MiB;
constexpr float WG8_SCALE = 32.0f;
constexpr size_t WS_WF1 = 0, WS_WF2 = 246 * MiB + 512 * 1024;
constexpr size_t WS_ZA = 18 * MiB;
constexpr size_t WS_QKV = 50 * MiB;
constexpr size_t WS_ZC = 98 * MiB;
constexpr size_t WS_P = 50 * MiB;
constexpr size_t WS_MG = 162 * MiB;
constexpr size_t WS_G = 114 * MiB;
constexpr size_t WS_H = 210 * MiB;
constexpr size_t WS_XH = 242 * MiB + 512 * 1024;
constexpr size_t WS_XS = 252 * MiB, XS_BANK = 512 * 1024;
constexpr size_t WS_END = 256 * MiB;
constexpr int CW_SEAM = 4096, SEAM_BANK = 64 * 64;

__device__ __forceinline__ unsigned f2bf(float f) { unsigned u = __builtin_bit_cast(unsigned, f); return (u + 0x7fffu + ((u >> 16) & 1u)) >> 16; }
__device__ __forceinline__ unsigned pk2(float lo, float hi) { unsigned r; asm("v_cvt_pk_bf16_f32 %0, %1, %2" : "=v"(r) : "v"(lo), "v"(hi)); return r; }
__device__ __forceinline__ unsigned pk4_fp8(float a, float b, float c, float d) { int w = 0; w = __builtin_amdgcn_cvt_pk_fp8_f32(a, b, w, false); w = __builtin_amdgcn_cvt_pk_fp8_f32(c, d, w, true); return (unsigned)w; }
__device__ __forceinline__ float bflo(unsigned w) { return __uint_as_float(w << 16); }
__device__ __forceinline__ float bfhi(unsigned w) { return __uint_as_float(w & 0xffff0000u); }
__device__ __forceinline__ float bf1(bf16_t b) { return __uint_as_float(((unsigned)b) << 16); }
__device__ __forceinline__ int fresh_tid(int wave) { int t = wave * 64 + (int)__builtin_amdgcn_mbcnt_hi(~0u, __builtin_amdgcn_mbcnt_lo(~0u, 0u)); asm volatile("" : "+v"(t)); return t; }
__device__ __forceinline__ float wave_sum(float v) {
#pragma unroll
    for (int o = 1; o < 64; o <<= 1) v += __shfl_xor(v, o);
    return v;
}
__device__ __forceinline__ float wave_max(float v) {
#pragma unroll
    for (int o = 1; o < 64; o <<= 1) v = fmaxf(v, __shfl_xor(v, o));
    return v;
}

__device__ __forceinline__ float gelu1(float v) {
    const float av = fabsf(v), t = __builtin_amdgcn_rcpf(av * 0.2316418882f + 1.0f);
    float q = t * 0.5307027145f + (-0.7265760135f); q = q * t + 0.7107068705f; q = q * t + (-0.142248368f); q = q * t + 0.127414796f; q = q * t;
    const float e = __builtin_amdgcn_exp2f((v * v) * (-0.72134752044f));
    const float m = v * (q * e);
    return v < 0.f ? m : v - m;
}
__device__ __forceinline__ float sigmoid1(float v) { return __builtin_amdgcn_rcpf(1.0f + __builtin_amdgcn_exp2f(v * -1.4426950408889634f)); }

struct Unit { int pm, pn, n; const bf16_t* A; const bf16_t* B; };
struct Gemm { int lda; int K; };
__host__ __device__ __forceinline__ int perm32(int rho) { const int n = rho >> 4, i = rho & 15; return 8 * (i >> 2) + 4 * n + (i & 3); }

constexpr int NXCD = 8, WGM = 4;
struct StaticOrder {
    int nM, nN, nwg, G, c; const bf16_t* A; const bf16_t* Bt; size_t atile, btile;
    __device__ void init(int M, int N, int G_, int c_, const bf16_t* A_, int lda, const bf16_t* Bt_, int K) { nM = M / 256; nN = N / 256; nwg = nM * nN; G = G_; c = c_; A = A_; Bt = Bt_; atile = (size_t)256 * lda; btile = (size_t)256 * K; }
    __device__ bool tile(int i, int& pm, int& pn) const {
        const long L = (long)i * G + c; if (L >= nwg) return false;
        int wgid = (int)L; { const int q = nwg / NXCD, r = nwg % NXCD, xcd = wgid % NXCD, off = wgid / NXCD; wgid = (xcd < r ? xcd * (q + 1) : r * (q + 1) + (xcd - r) * q) + off; }
        const int nig = WGM * nN, gid = wgid / nig, fm = gid * WGM, gsz = (nM - fm) < WGM ? (nM - fm) : WGM;
        pm = fm + ((wgid % nig) % gsz); pn = (wgid % nig) / gsz; return true;
    }
    __device__ bool next(int i, Unit& u) const { if (!tile(i, u.pm, u.pn)) return false; u.n = 0; u.A = A + u.pm * atile; u.B = Bt + u.pn * btile; return true; }
};
struct BranchOrder {
    StaticOrder so; const bf16_t* A0; const bf16_t* Bt; size_t bstride;
    __device__ bool next(int i, Unit& u) const {
        const int ti = i / 3, n = i - 3 * ti;
        if (!so.tile(ti, u.pm, u.pn)) return false;
        u.n = n; const size_t aoff = (size_t)(n > 0 ? 1 : 0) * ((WS_H - WS_ZA) / 2) + (size_t)(n > 1 ? 1 : 0) * 512;
        u.A = A0 + aoff + u.pm * so.atile; u.B = Bt + (size_t)n * bstride + u.pn * so.btile; return true;
    }
};

struct EpiIn {
    static constexpr bool PERM = true, AFTER_DRAIN = false, CHAIN = false, FP8 = false;
    bf16_t *ZA, *QKV, *ZC;
    __device__ __forceinline__ void operator()(const f32x4 (&acc)[2][2][4][2], const Unit& u, int wr, int wc, int fr, int fq) const {
        const int pn = u.pn; const int row0 = u.pm * 256 + wr * 64 + fr;
        bf16_t* base; int ldc, colt; bool act = false; float sc = 1.f;
        if (pn < 4) { base = ZA; ldc = 1024; colt = pn * 256; act = true; }
        else if (pn < 10) { base = QKV; ldc = 1536; colt = (pn - 4) * 256; if (pn < 6) sc = C2; }
        else { base = ZC; ldc = 512; colt = (pn - 10) * 256; }
        const int col0 = colt + wc * 32 + 8 * fq;
#pragma unroll
        for (int ai = 0; ai < 2; ++ai)
#pragma unroll
            for (int m = 0; m < 4; ++m) { bf16_t* rowp = base + (size_t)(row0 + ai * 128 + m * 16) * ldc + col0;
#pragma unroll
                for (int bj = 0; bj < 2; ++bj) { f32x4 v0 = acc[ai][bj][m][0], v1 = acc[ai][bj][m][1];
                    if (act) {
#pragma unroll
                        for (int e = 0; e < 4; ++e) { v0[e] = gelu1(v0[e]); v1[e] = gelu1(v1[e]); }
                    }
                    v0 = v0 * sc; v1 = v1 * sc;
                    u32x4 w; w.x = pk2(v0[0], v0[1]); w.y = pk2(v0[2], v0[3]); w.z = pk2(v1[0], v1[1]); w.w = pk2(v1[2], v1[3]);
                    *(u32x4*)(rowp + bj * 128) = w; } }
    }
};
struct EpiGate {
    static constexpr bool PERM = true, AFTER_DRAIN = false, CHAIN = false, FP8 = true;
    unsigned char* G8;
    __device__ __forceinline__ void operator()(const f32x4 (&acc)[2][2][4][2], const Unit& u, int wr, int wc, int fr, int fq) const {
        const int row0 = u.pm * 256 + wr * 64 + fr, col0 = u.pn * 256 + wc * 32 + 8 * fq;
#pragma unroll
        for (int ai = 0; ai < 2; ++ai)
#pragma unroll
            for (int m = 0; m < 4; ++m) { unsigned char* rowp = G8 + (size_t)(row0 + ai * 128 + m * 16) * 3072 + col0;
#pragma unroll
                for (int bj = 0; bj < 2; ++bj) { unsigned q[8];
#pragma unroll
                    for (int e = 0; e < 4; ++e) { q[e] = (unsigned)fminf(sigmoid1(acc[ai][bj][m][0][e] * (1.0f / WG8_SCALE)) * 256.0f, 255.0f); q[4 + e] = (unsigned)fminf(sigmoid1(acc[ai][bj][m][1][e] * (1.0f / WG8_SCALE)) * 256.0f, 255.0f); }
                    u32x2 w; w.x = q[0] | (q[1] << 8) | (q[2] << 16) | (q[3] << 24); w.y = q[4] | (q[5] << 8) | (q[6] << 16) | (q[7] << 24);
                    *(u32x2*)(rowp + bj * 128) = w; } }
    }
};
__device__ __forceinline__ void gate8(const u32x2 w, f32x4& g0, f32x4& g1) {
    g0 = (f32x4){(float)(w.x & 0xffu), (float)((w.x >> 8) & 0xffu), (float)((w.x >> 16) & 0xffu), (float)(w.x >> 24)};
    g1 = (f32x4){(float)(w.y & 0xffu), (float)((w.y >> 8) & 0xffu), (float)((w.y >> 16) & 0xffu), (float)(w.y >> 24)};
    g0 = g0 * (1.0f / 256.0f) + (0.5f / 256.0f); g1 = g1 * (1.0f / 256.0f) + (0.5f / 256.0f);
}
struct EpiBranch {
    static constexpr bool PERM = true, AFTER_DRAIN = false, CHAIN = true, FP8 = false;
    const unsigned char* G8; bf16_t* MG;
    __device__ __forceinline__ void operator()(f32x4 (&acc)[2][2][4][2], const Unit& u, int wr, int wc, int fr, int fq) const {
        const int n = u.n; const int row0 = u.pm * 256 + wr * 64 + fr, col0 = u.pn * 256 + wc * 32 + 8 * fq;
#pragma unroll
        for (int ai = 0; ai < 2; ++ai) {
            u32x2 gw[4][2], hw[4][2];
#pragma unroll
            for (int m = 0; m < 4; ++m)
#pragma unroll
                for (int bj = 0; bj < 2; ++bj) { const unsigned char* gp = G8 + (size_t)(row0 + ai * 128 + m * 16) * 3072 + n * 1024 + col0 + bj * 128;
                    gw[m][bj] = *(const u32x2*)gp; hw[m][bj] = (n < 2) ? *(const u32x2*)(gp + 1024) : (u32x2){0u, 0u}; }
#pragma unroll
            for (int m = 0; m < 4; ++m) { const size_t row = (size_t)(row0 + ai * 128 + m * 16);
#pragma unroll
                for (int bj = 0; bj < 2; ++bj) { const int col = col0 + bj * 128;
                    f32x4 g0, g1; gate8(gw[m][bj], g0, g1);
                    if (n < 2) { f32x4 h0, h1; gate8(hw[m][bj], h0, h1);
#pragma unroll
                        for (int e = 0; e < 4; ++e) { g0[e] *= __builtin_amdgcn_rcpf(h0[e]); g1[e] *= __builtin_amdgcn_rcpf(h1[e]); }
                        acc[ai][bj][m][0] *= g0; acc[ai][bj][m][1] *= g1;
                    } else { const f32x4 v0 = acc[ai][bj][m][0] * g0, v1 = acc[ai][bj][m][1] * g1;
                        u32x4 w; w.x = pk2(v0[0], v0[1]); w.y = pk2(v0[2], v0[3]); w.z = pk2(v1[0], v1[1]); w.w = pk2(v1[2], v1[3]); *(u32x4*)(MG + row * 1024 + col) = w; } } }
            asm volatile("" ::: "memory");
        }
    }
};
struct EpiF32 {
    static constexpr bool PERM = true, AFTER_DRAIN = false, CHAIN = false, FP8 = false;
    float* O;
    __device__ __forceinline__ void operator()(const f32x4 (&acc)[2][2][4][2], const Unit& u, int wr, int wc, int fr, int fq) const {
        const int row0 = u.pm * 256 + wr * 64 + fr, col0 = u.pn * 256 + wc * 32 + 8 * fq;
#pragma unroll
        for (int ai = 0; ai < 2; ++ai)
#pragma unroll
            for (int m = 0; m < 4; ++m) { float* rowp = O + (size_t)(row0 + ai * 128 + m * 16) * 1024 + col0;
#pragma unroll
                for (int bj = 0; bj < 2; ++bj) { *(f32x4*)(rowp + bj * 128) = acc[ai][bj][m][0]; *(f32x4*)(rowp + bj * 128 + 4) = acc[ai][bj][m][1]; } }
    }
};
struct EpiSwiglu {
    static constexpr bool PERM = true, AFTER_DRAIN = false, CHAIN = false, FP8 = false;
    bf16_t* F;
    __device__ __forceinline__ void operator()(const f32x4 (&acc)[2][2][4][2], const Unit& u, int wr, int wc, int fr, int fq) const {
        const int row0 = u.pm * 256 + wr * 64 + fr, col0 = u.pn * 128 + wc * 32 + 8 * fq;
#pragma unroll
        for (int ai = 0; ai < 2; ++ai)
#pragma unroll
            for (int m = 0; m < 4; ++m) { bf16_t* rowp = F + (size_t)(row0 + ai * 128 + m * 16) * DFF + col0;
                f32x4 v0, v1;
#pragma unroll
                for (int e = 0; e < 4; ++e) { const float g0 = acc[ai][0][m][0][e], g1 = acc[ai][0][m][1][e];
                    v0[e] = g0 * sigmoid1(g0) * acc[ai][1][m][0][e]; v1[e] = g1 * sigmoid1(g1) * acc[ai][1][m][1][e]; }
                u32x4 w; w.x = pk2(v0[0], v0[1]); w.y = pk2(v0[2], v0[3]); w.z = pk2(v1[0], v1[1]); w.w = pk2(v1[2], v1[3]);
                *(u32x4*)rowp = w; }
    }
};

#define EX_LAS __attribute__((address_space(3)))
struct PanelRms {
    unsigned long long* xbuf;
    __device__ __forceinline__ void run(const f32x4 (&v)[2][2][4][2], const Unit& u, int wr, int wc, int fr, int fq, EX_LAS unsigned char* lds, int wid, int lane) const {
        EX_LAS float* P = (EX_LAS float*)lds;
        EX_LAS float* S = (EX_LAS float*)(lds + 4096);
#pragma unroll
        for (int ai = 0; ai < 2; ++ai)
#pragma unroll
            for (int m = 0; m < 4; ++m) {
                float q = 0.f;
#pragma unroll
                for (int bj = 0; bj < 2; ++bj)
#pragma unroll
                    for (int n = 0; n < 2; ++n) { const f32x4 x = v[ai][bj][m][n]; q += (x[0] * x[0] + x[1] * x[1]) + (x[2] * x[2] + x[3] * x[3]); }
                q += __shfl_xor(q, 16); q += __shfl_xor(q, 32);
                if (fq == 0) P[(ai * 128 + wr * 64 + m * 16 + fr) * 4 + wc] = q;
            }
        asm volatile("s_waitcnt lgkmcnt(0)" ::: "memory"); __builtin_amdgcn_s_barrier(); asm volatile("" ::: "memory");
        const int row = wid * 32 + (lane & 31);
        if (lane < 32) {
            const float tot = (P[row * 4 + 0] + P[row * 4 + 1]) + (P[row * 4 + 2] + P[row * 4 + 3]);
            unsigned long long* slot = xbuf + (size_t)(u.pm * 256 + row) * 4;
            __hip_atomic_store(slot + u.pn, (1ull << 32) | (unsigned long long)__float_as_uint(tot), __ATOMIC_RELAXED, __HIP_MEMORY_SCOPE_AGENT);
            float ss = 0.f;
#pragma unroll
            for (int t = 0; t < 4; ++t) { unsigned long long w = 0ull;
#pragma unroll 1
                for (unsigned it = 0; it < (1u << 20); ++it) { w = __hip_atomic_load(slot + t, __ATOMIC_RELAXED, __HIP_MEMORY_SCOPE_AGENT); if ((w >> 32) != 0ull) break; __builtin_amdgcn_s_sleep(1); }
                ss += __uint_as_float((unsigned)w); }
            S[row] = 1.0f / sqrtf(ss * (1.0f / 1024.0f) + EPS);
        }
        asm volatile("s_waitcnt vmcnt(0) lgkmcnt(0)" ::: "memory"); __builtin_amdgcn_s_barrier(); asm volatile("" ::: "memory");
    }
};
template <bool BASE_BF>
struct EpiRmsRes {
    static constexpr bool PERM = true, AFTER_DRAIN = true, CHAIN = false, FP8 = false;
    const void* base; float* out_f32; bf16_t* out_bf; const float* gpost; const float* gnext; bf16_t* xn; unsigned char* xn8; PanelRms st1, st2;
    __device__ __forceinline__ void operator()(const f32x4 (&)[2][2][4][2], const Unit&, int, int, int, int) const {}
    __device__ __forceinline__ void fused(f32x4 (&acc)[2][2][4][2], const Unit& u, int wr, int wc, int fr, int fq, EX_LAS unsigned char* lds, int wid, int lane) const {
        const EX_LAS float* S = (const EX_LAS float*)(lds + 4096);
        const int col0 = u.pn * 256 + wc * 32 + 8 * fq;
        u32x4 preb[2][4][2]; f32x4 pref[4][2][2];
        if constexpr (BASE_BF) {
#pragma unroll
            for (int ai = 0; ai < 2; ++ai)
#pragma unroll
                for (int m = 0; m < 4; ++m) { const size_t off = (size_t)(u.pm * 256 + ai * 128 + wr * 64 + m * 16 + fr) * 1024 + col0;
#pragma unroll
                    for (int bj = 0; bj < 2; ++bj) preb[ai][m][bj] = *(const u32x4*)((const bf16_t*)base + off + bj * 128); }
        } else {
#pragma unroll
            for (int m = 0; m < 4; ++m) { const size_t off = (size_t)(u.pm * 256 + wr * 64 + m * 16 + fr) * 1024 + col0;
#pragma unroll
                for (int bj = 0; bj < 2; ++bj)
#pragma unroll
                    for (int n = 0; n < 2; ++n) pref[m][bj][n] = *(const f32x4*)((const float*)base + off + bj * 128 + n * 4); }
        }
        st1.run(acc, u, wr, wc, fr, fq, lds, wid, lane);
#pragma unroll
        for (int ai = 0; ai < 2; ++ai)
#pragma unroll
            for (int m = 0; m < 4; ++m) { const int r = ai * 128 + wr * 64 + m * 16 + fr; const float sr = S[r]; const size_t off = (size_t)(u.pm * 256 + r) * 1024 + col0;
#pragma unroll
                for (int bj = 0; bj < 2; ++bj) {
                    f32x4 b0, b1;
                    if constexpr (BASE_BF) { const u32x4 w = preb[ai][m][bj]; b0 = (f32x4){bflo(w.x), bfhi(w.x), bflo(w.y), bfhi(w.y)}; b1 = (f32x4){bflo(w.z), bfhi(w.z), bflo(w.w), bfhi(w.w)}; }
                    else { b0 = (ai == 0) ? pref[m][bj][0] : *(const f32x4*)((const float*)base + off + bj * 128); b1 = (ai == 0) ? pref[m][bj][1] : *(const f32x4*)((const float*)base + off + bj * 128 + 4); }
                    const f32x4 g0 = *(const f32x4*)(gpost + col0 + bj * 128), g1 = *(const f32x4*)(gpost + col0 + bj * 128 + 4);
                    acc[ai][bj][m][0] = b0 + acc[ai][bj][m][0] * sr * g0; acc[ai][bj][m][1] = b1 + acc[ai][bj][m][1] * sr * g1; }
                asm volatile("" : "+v"(acc[ai][0][m][0]), "+v"(acc[ai][0][m][1]), "+v"(acc[ai][1][m][0]), "+v"(acc[ai][1][m][1]));
                if (m & 1) asm volatile("" ::: "memory"); }
        if (gnext) st2.run(acc, u, wr, wc, fr, fq, lds, wid, lane);
#pragma unroll
        for (int ai = 0; ai < 2; ++ai)
#pragma unroll
            for (int m = 0; m < 4; ++m) { const int r = ai * 128 + wr * 64 + m * 16 + fr; const float sr = S[r]; const size_t off = (size_t)(u.pm * 256 + r) * 1024 + col0;
#pragma unroll
                for (int bj = 0; bj < 2; ++bj) { const f32x4 x0 = acc[ai][bj][m][0], x1 = acc[ai][bj][m][1];
                    if (out_f32) { *(f32x4*)(out_f32 + off + bj * 128) = x0; *(f32x4*)(out_f32 + off + bj * 128 + 4) = x1; }
                    else { u32x4 w; w.x = pk2(x0[0], x0[1]); w.y = pk2(x0[2], x0[3]); w.z = pk2(x1[0], x1[1]); w.w = pk2(x1[2], x1[3]); *(u32x4*)(out_bf + off + bj * 128) = w; }
                    if (gnext) { const f32x4 g0 = *(const f32x4*)(gnext + col0 + bj * 128), g1 = *(const f32x4*)(gnext + col0 + bj * 128 + 4);
                        const f32x4 h0 = x0 * sr * g0, h1 = x1 * sr * g1;
                        u32x4 w; w.x = pk2(h0[0], h0[1]); w.y = pk2(h0[2], h0[3]); w.z = pk2(h1[0], h1[1]); w.w = pk2(h1[2], h1[3]);
                        *(u32x4*)(xn + off + bj * 128) = w;
                        if (xn8) { u32x2 w8; w8.x = pk4_fp8(h0[0], h0[1], h0[2], h0[3]); w8.y = pk4_fp8(h1[0], h1[1], h1[2], h1[3]); *(u32x2*)(xn8 + off + bj * 128) = w8; } } }
                asm volatile("" ::: "memory"); }
    }
};

#define PG8_LAS __attribute__((address_space(3)))
constexpr int BK = 64, HALF = 128, HTB = HALF * BK * 2, STAGE_BYTES = 8 * HTB;
__host__ __device__ __forceinline__ int lds_byte(int r, int c) { const int st = (r >> 4) * 2 + (c >> 5), rr = r & 15, cc = c & 31, ob = rr * 64 + cc * 2; return st * 1024 + (ob ^ (((ob >> 9) & 1) << 5)); }
__host__ __device__ __forceinline__ void stage_rc(int b, int& R, int& C) { const int st = b / 1024, sb = b % 1024, swz = sb ^ (((sb >> 9) & 1) << 5); R = (st >> 1) * 16 + swz / 64; C = (st & 1) * 32 + (swz % 64) / 2; }

template <class Epi, class Sched>
__device__ __forceinline__ void gemm_phase(PG8_LAS unsigned char* lds, const Gemm g, const Sched& S, const Epi& E, int wave_) {
    const int tid_ = fresh_tid(wave_);
    const int tid = tid_, wid = __builtin_amdgcn_readfirstlane(tid >> 6), lane = tid & 63, wr = wid >> 2, wc = wid & 3, fr = lane & 15, fq = lane >> 4;
    const int K = g.K, nt = K / BK;
    unsigned voffA[2], voffB[2];
#pragma unroll
    for (int i = 0; i < 2; ++i) { int R, C; stage_rc(tid * 16 + i * 8192, R, C); const int Rb = Epi::PERM ? ((R & ~31) + perm32(R & 31)) : R;
        voffA[i] = (unsigned)(R * g.lda + C) * 2u; voffB[i] = (unsigned)(Rb * K + C) * 2u; }
    const size_t kstep = (size_t)(BK * 2);
    const size_t hstepA = (size_t)HALF * g.lda * 2, hstepB = (size_t)HALF * K * 2;
    const unsigned ldsw = (unsigned)wid * 1024u;
    const int aoff = lds_byte(wr * 64 + fr, fq * 8), boff = lds_byte(wc * 32 + fr, fq * 8);
#define PG8_SA(b, h) (((b) * 2 + (h)) * HTB)
#define PG8_SB(b, h) ((4 + (b) * 2 + (h)) * HTB)
#define PG8_STAGE(bufoff, gbase, voff) do { _Pragma("unroll") for (int _i = 0; _i < 2; ++_i) \
        __builtin_amdgcn_global_load_lds((const unsigned*)((const char*)(gbase) + (voff)[_i]), (PG8_LAS unsigned*)(lds + (bufoff) + ldsw + _i * 8192), 16, 0, 0); } while (0)
    PG8_LAS unsigned char* const fa = lds + aoff; PG8_LAS unsigned char* fb_ = lds + 4 * HTB + boff; asm volatile("" : "+v"(fb_)); PG8_LAS unsigned char* const fb = fb_;
#define PG8_FA(b, h) (((b) * 2 + (h)) * HTB)
#define PG8_FB(b, h) (((b) * 2 + (h)) * HTB)
#define PG8_LDA(dst, b, h) do { if constexpr (Epi::FP8) { _Pragma("unroll") for (int m = 0; m < 4; ++m) dst##8[m] = __builtin_shufflevector(*(const PG8_LAS v4i_t*)(fa + PG8_FA(b, h) + m * 2048), *(const PG8_LAS v4i_t*)(fa + PG8_FA(b, h) + m * 2048 + 1024), 0, 1, 2, 3, 4, 5, 6, 7); } \
        else { _Pragma("unroll") for (int m = 0; m < 4; ++m) _Pragma("unroll") for (int k = 0; k < 2; ++k) dst[m][k] = *(const PG8_LAS bf16x8*)(fa + PG8_FA(b, h) + m * 2048 + k * 1024); } } while (0)
#define PG8_LDB(dst, b, h) do { if constexpr (Epi::FP8) { _Pragma("unroll") for (int n = 0; n < 2; ++n) dst##8[n] = __builtin_shufflevector(*(const PG8_LAS v4i_t*)(fb + PG8_FB(b, h) + n * 2048), *(const PG8_LAS v4i_t*)(fb + PG8_FB(b, h) + n * 2048 + 1024), 0, 1, 2, 3, 4, 5, 6, 7); } \
        else { _Pragma("unroll") for (int n = 0; n < 2; ++n) _Pragma("unroll") for (int k = 0; k < 2; ++k) dst[n][k] = *(const PG8_LAS bf16x8*)(fb + PG8_FB(b, h) + n * 2048 + k * 1024); } } while (0)
#define PG8_MMA(ai, bj, At, Bt) do { __builtin_amdgcn_s_setprio(1); \
        if constexpr (Epi::FP8) { _Pragma("unroll") for (int m = 0; m < 4; ++m) _Pragma("unroll") for (int n = 0; n < 2; ++n) \
            asm volatile("v_mfma_f32_16x16x128_f8f6f4 %0, %1, %2, %0" : "+v"(acc[ai][bj][m][n]) : "v"(Bt##8[n]), "v"(At##8[m])); }   \
        else { _Pragma("unroll") for (int m = 0; m < 4; ++m) _Pragma("unroll") for (int n = 0; n < 2; ++n) _Pragma("unroll") for (int k = 0; k < 2; ++k) \
            acc[ai][bj][m][n] = __builtin_amdgcn_mfma_f32_16x16x32_bf16(Bt[n][k], At[m][k], acc[ai][bj][m][n], 0, 0, 0); } \
        __builtin_amdgcn_s_setprio(0); } while (0)
#define PG8_WAIT_V(n) asm volatile("s_waitcnt vmcnt(" #n ")" ::: "memory")
#define PG8_WAIT_L(n) asm volatile("s_waitcnt lgkmcnt(" #n ")" ::: "memory")
#define PG8_BAR __builtin_amdgcn_s_barrier()
#define PG8_SCHED __builtin_amdgcn_sched_barrier(0)
    Unit cur, nxt; int ui = 0;
    if (!S.next(0, cur)) return;
    f32x4 acc[2][2][4][2];
#pragma unroll
    for (int a = 0; a < 2; ++a)
#pragma unroll
        for (int b = 0; b < 2; ++b)
#pragma unroll
            for (int m = 0; m < 4; ++m)
#pragma unroll
                for (int n = 0; n < 2; ++n) acc[a][b][m][n] = (f32x4){0.f, 0.f, 0.f, 0.f};
    bf16x8 At[4][2], B0[2][2], B1[2][2]; v8i_t At8[4], B08[2], B18[2];
    const char* cA = (const char*)cur.A; const char* cB = (const char*)cur.B;
    PG8_STAGE(PG8_SB(0, 0), cB, voffB); PG8_STAGE(PG8_SB(0, 1), cB + hstepB, voffB); PG8_STAGE(PG8_SA(0, 0), cA, voffA); PG8_STAGE(PG8_SA(0, 1), cA + hstepA, voffA);
    if (wr == 1) PG8_BAR;
    PG8_WAIT_V(2); PG8_BAR;
    PG8_STAGE(PG8_SB(1, 0), cB + kstep, voffB); PG8_STAGE(PG8_SA(1, 0), cA + kstep, voffA); PG8_STAGE(PG8_SB(1, 1), cB + hstepB + kstep, voffB);
    PG8_WAIT_V(6); PG8_BAR;
    for (;;) {
        const bool has_next = S.next(ui + 1, nxt);
        const char* nA = has_next ? (const char*)nxt.A : cA; const char* nB = has_next ? (const char*)nxt.B : cB;
#pragma unroll 1
        for (int t = 0; t < nt; t += 2) {
            const bool last = (t == nt - 2);
            const char* a1 = cA + (size_t)(t + 1) * kstep;
            const char* a2 = last ? nA : cA + (size_t)(t + 2) * kstep; const char* b2 = last ? nB : cB + (size_t)(t + 2) * kstep;
            const char* a3 = a2 + kstep; const char* b3 = b2 + kstep;
            PG8_LDB(B0, 0, 0); PG8_LDB(B1, 0, 1); PG8_SCHED; PG8_LDA(At, 0, 0); PG8_STAGE(PG8_SA(1, 1), a1 + hstepA, voffA);
            PG8_WAIT_V(8); PG8_WAIT_L(0); PG8_BAR; PG8_MMA(0, 0, At, B0); PG8_MMA(0, 1, At, B1); PG8_BAR; PG8_SCHED;
            PG8_LDA(At, 0, 1); PG8_STAGE(PG8_SB(0, 0), b2, voffB); PG8_STAGE(PG8_SB(0, 1), b2 + hstepB, voffB); PG8_STAGE(PG8_SA(0, 0), a2, voffA);
            PG8_WAIT_V(8); PG8_WAIT_L(0); PG8_BAR; PG8_MMA(1, 0, At, B0); PG8_MMA(1, 1, At, B1); PG8_BAR; PG8_SCHED;
            PG8_LDB(B0, 1, 0); PG8_LDB(B1, 1, 1); PG8_SCHED; PG8_LDA(At, 1, 0); PG8_STAGE(PG8_SA(0, 1), a2 + hstepA, voffA);
            PG8_WAIT_V(8); PG8_WAIT_L(0); PG8_BAR; PG8_MMA(0, 0, At, B0); PG8_MMA(0, 1, At, B1); PG8_BAR; PG8_SCHED;
            PG8_LDA(At, 1, 1); PG8_STAGE(PG8_SB(1, 0), b3, voffB); PG8_STAGE(PG8_SB(1, 1), b3 + hstepB, voffB); PG8_STAGE(PG8_SA(1, 0), a3, voffA);
            PG8_WAIT_V(8); PG8_WAIT_L(0); PG8_BAR; PG8_MMA(1, 0, At, B0); PG8_MMA(1, 1, At, B1); PG8_BAR; PG8_SCHED;
        }
        if (wr == 0) PG8_BAR;
        if constexpr (Epi::FP8) asm volatile("s_nop 15\n\ts_nop 15" ::: "memory");
        if constexpr (!Epi::AFTER_DRAIN) E(acc, cur, wr, wc, fr, fq);
        if (!has_next) break;
        if (!Epi::CHAIN || cur.n == 2) {
#pragma unroll
            for (int a = 0; a < 2; ++a)
#pragma unroll
                for (int b = 0; b < 2; ++b)
#pragma unroll
                    for (int m = 0; m < 4; ++m)
#pragma unroll
                        for (int n = 0; n < 2; ++n) acc[a][b][m][n] = (f32x4){0.f, 0.f, 0.f, 0.f};
        }
        cur = nxt; cA = nA; cB = nB; ++ui;
        if (wr == 1) PG8_BAR;
    }
    PG8_WAIT_V(0);
    PG8_BAR;
    if constexpr (Epi::AFTER_DRAIN) E.fused(acc, cur, wr, wc, fr, fq, lds, wid, lane);
#undef PG8_SA
#undef PG8_SB
#undef PG8_STAGE
#undef PG8_LDA
#undef PG8_LDB
#undef PG8_MMA
#undef PG8_FA
#undef PG8_FB
#undef PG8_WAIT_V
#undef PG8_WAIT_L
#undef PG8_BAR
#undef PG8_SCHED
}
#define GEMM_PHASE(EpiT, SchedT, g, S, E) gemm_phase<EpiT, SchedT>((PG8_LAS unsigned char*)lds, g, S, E, my_wave)

struct Ctx {
    unsigned char* lds; int tid, lane, wave, gw, ngw;
};
struct TDesc { const float* W; bf16_t* WT; int K, N, mode, item; };
__device__ __forceinline__ void titem_load(const TDesc& d, int lane, f32x4 (&v)[8]) {
    const int nblk = d.N / 32, kb = d.item / nblk, nb = d.item % nblk, k0 = 64 * kb, n0 = 32 * nb;
#pragma unroll
    for (int i = 0; i < 8; ++i) v[i] = __builtin_nontemporal_load((const f32x4*)(d.W + (size_t)(k0 + 8 * i + (lane >> 3)) * d.N + n0 + 4 * (lane & 7)));
}
__device__ __forceinline__ void titem_store(const TDesc& d, int lane, const f32x4 (&v)[8], float* scr) {
    const int nblk = d.N / 32, kb = d.item / nblk, nb = d.item % nblk, k0 = 64 * kb, n0 = 32 * nb;
#pragma unroll
    for (int i = 0; i < 8; ++i) { float* q = scr + (8 * i + (lane >> 3)) * 33 + 4 * (lane & 7); q[0] = v[i][0]; q[1] = v[i][1]; q[2] = v[i][2]; q[3] = v[i][3]; }
    __builtin_amdgcn_wave_barrier(); asm volatile("s_waitcnt lgkmcnt(0)" ::: "memory");
    int d0 = n0;
    if (d.mode == 1) { const int half = d.N / 2; const int j = (n0 < half) ? n0 : n0 - half; d0 = (j / 128) * 256 + (j % 128) + ((n0 < half) ? 0 : 128); }
    const int c = lane & 7;
#pragma unroll
    for (int j = 0; j < 4; ++j) { const int n = (lane >> 3) + 8 * j; const float* sp = scr + (8 * c) * 33 + n;
        if (d.mode == 2) {
            u32x2 o; o.x = pk4_fp8(sp[0 * 33] * WG8_SCALE, sp[1 * 33] * WG8_SCALE, sp[2 * 33] * WG8_SCALE, sp[3 * 33] * WG8_SCALE); o.y = pk4_fp8(sp[4 * 33] * WG8_SCALE, sp[5 * 33] * WG8_SCALE, sp[6 * 33] * WG8_SCALE, sp[7 * 33] * WG8_SCALE);
            *(u32x2*)((unsigned char*)d.WT + (size_t)(d0 - d.N / 2 + n) * d.K + k0 + 8 * c) = o; continue; }
        u32x4 o; o.x = pk2(sp[0 * 33], sp[1 * 33]); o.y = pk2(sp[2 * 33], sp[3 * 33]); o.z = pk2(sp[4 * 33], sp[5 * 33]); o.w = pk2(sp[6 * 33], sp[7 * 33]);
        *(u32x4*)(d.WT + (size_t)(d0 + n) * d.K + k0 + 8 * c) = o; }
    __builtin_amdgcn_wave_barrier(); asm volatile("s_waitcnt lgkmcnt(0)" ::: "memory");
}
struct MixerW { const float *w_in, *w_branch, *w_out, *pool_w; unsigned char* ws;
    static constexpr int I_IN = 16 * 192, I_B = 8 * 32, I_O = 16 * 32, I_P = 2 * 4, NIT = I_IN + 3 * I_B + I_O + 4 * I_P;
    __device__ __forceinline__ TDesc desc(int it) const {
        int r = it;
        if (r < I_IN) { const bool gate = (r % 192) >= 96;
            return TDesc{w_in, (bf16_t*)(ws + (gate ? WS_WG8 : WS_WIN)), 1024, IN_TOTAL, gate ? 2 : 0, r}; }
        r -= I_IN;
        if (r < 3 * I_B) { const int n = r / I_B; return TDesc{w_branch + (size_t)n * 512 * 1024, (bf16_t*)(ws + WS_WB) + (size_t)n * 1024 * 512, 512, 1024, 0, r % I_B}; }
        r -= 3 * I_B;
        if (r < I_O) return TDesc{w_out, (bf16_t*)(ws + WS_WOUT), 1024, 1024, 0, r};
        r -= I_O;
        { const int g = r / I_P; return TDesc{pool_w + (size_t)g * 128 * 128, (bf16_t*)(ws + WS_WPOOL) + (size_t)g * 128 * 128, 128, 128, 0, r % I_P}; }
    }
};
struct FfnW { const float *w1, *w2; unsigned char* ws;
    static constexpr int I_1 = 16 * 176, I_2 = 44 * 32, NIT = I_1 + I_2;
    __device__ __forceinline__ TDesc desc(int it) const {
        if (it < I_1) return TDesc{w1, (bf16_t*)(ws + WS_WF1), 1024, 2 * DFF, 1, it};
        return TDesc{w2, (bf16_t*)(ws + WS_WF2), DFF, 1024, 0, it - I_1};
    }
};
template <class Wset>
__device__ __forceinline__ void convert_weights(const Ctx& C, const Wset& ww) {
    float* scr = (float*)(C.lds + C.wave * 16384);
    int it = C.gw; if (it >= Wset::NIT) return;
    TDesc d = ww.desc(it); f32x4 v[8]; titem_load(d, C.lane, v);
#pragma unroll 1
    for (;;) {
        const int nx = it + C.ngw; const bool hn = nx < Wset::NIT;
        TDesc dn = d; f32x4 vn[8];
        if (hn) { dn = ww.desc(nx); titem_load(dn, C.lane, vn); }
        titem_store(d, C.lane, v, scr);
        if (!hn) break;
        d = dn; it = nx;
#pragma unroll
        for (int i = 0; i < 8; ++i) v[i] = vn[i];
    }
}
__device__ __forceinline__ void convert_mixer_weights(const Ctx& C, const float* w_in, const float* w_branch, const float* w_out, const float* pool_w, unsigned char* ws) {
    convert_weights(C, MixerW{w_in, w_branch, w_out, pool_w, ws});
}
__device__ __forceinline__ void convert_ffn_weights(const Ctx& C, const float* w1, const float* w2, unsigned char* ws) {
    convert_weights(C, FfnW{w1, w2, ws});
}
__device__ __forceinline__ void rms_rows4_to_bf16(const float* x, const float* g, bf16_t* h, unsigned char* h8, int m0, int mstep, int lane) {
    f32x4 v[4][4]; float ss[4];
#pragma unroll
    for (int r = 0; r < 4; ++r) { const int m = m0 + r * mstep; const bool ok = m < MTOK; ss[r] = 0.f;
#pragma unroll
        for (int j = 0; j < 4; ++j) { v[r][j] = ok ? *((const f32x4*)(x + (size_t)m * DM) + lane + 64 * j) : (f32x4){0.f, 0.f, 0.f, 0.f}; } }
#pragma unroll
    for (int r = 0; r < 4; ++r) {
#pragma unroll
        for (int j = 0; j < 4; ++j) ss[r] += (v[r][j][0] * v[r][j][0] + v[r][j][1] * v[r][j][1]) + (v[r][j][2] * v[r][j][2] + v[r][j][3] * v[r][j][3]);
        ss[r] = wave_sum(ss[r]); }
#pragma unroll
    for (int r = 0; r < 4; ++r) { const int m = m0 + r * mstep; if (m >= MTOK) continue;
        const float rstd = 1.0f / sqrtf(ss[r] * (1.f / DM) + EPS);
#pragma unroll
        for (int j = 0; j < 4; ++j) { const f32x4 gg = *((const f32x4*)g + lane + 64 * j); const f32x4 o = v[r][j] * rstd * gg;
            u32x2 w; w.x = pk2(o[0], o[1]); w.y = pk2(o[2], o[3]); *((u32x2*)(h + (size_t)m * DM) + lane + 64 * j) = w;
            *((unsigned*)(h8 + (size_t)m * DM) + lane + 64 * j) = pk4_fp8(o[0], o[1], o[2], o[3]); } }
}
__device__ __forceinline__ void rms_row_to_bf16(const float* xrow, const float* g, bf16_t* hrow, int lane) {
    f32x4 v[4]; float ss = 0.f;
#pragma unroll
    for (int j = 0; j < 4; ++j) { v[j] = *((const f32x4*)xrow + lane + 64 * j); ss += (v[j][0] * v[j][0] + v[j][1] * v[j][1]) + (v[j][2] * v[j][2] + v[j][3] * v[j][3]); }
    const float rstd = 1.0f / sqrtf(wave_sum(ss) * (1.f / DM) + EPS);
#pragma unroll
    for (int j = 0; j < 4; ++j) { const f32x4 gg = *((const f32x4*)g + lane + 64 * j); const f32x4 o = v[j] * rstd * gg;
        u32x2 w; w.x = pk2(o[0], o[1]); w.y = pk2(o[2], o[3]); *((u32x2*)hrow + lane + 64 * j) = w; }
}
__device__ __forceinline__ void res_norm_row(const float* orow, const float* xin, float* xout, const float* gpost, const float* gnext, bf16_t* hrow, unsigned char* h8row, int lane) {
    f32x4 o[4], x[4]; float ss = 0.f;
#pragma unroll
    for (int j = 0; j < 4; ++j) { o[j] = *((const f32x4*)orow + lane + 64 * j); x[j] = *((const f32x4*)xin + lane + 64 * j); ss += (o[j][0] * o[j][0] + o[j][1] * o[j][1]) + (o[j][2] * o[j][2] + o[j][3] * o[j][3]); }
    const float rstd = 1.0f / sqrtf(wave_sum(ss) * (1.f / DM) + EPS);
    float s2 = 0.f;
#pragma unroll
    for (int j = 0; j < 4; ++j) { const f32x4 gg = *((const f32x4*)gpost + lane + 64 * j); x[j] = x[j] + o[j] * rstd * gg; *((f32x4*)xout + lane + 64 * j) = x[j];
        s2 += (x[j][0] * x[j][0] + x[j][1] * x[j][1]) + (x[j][2] * x[j][2] + x[j][3] * x[j][3]); }
    if (gnext) {
        const float r2 = 1.0f / sqrtf(wave_sum(s2) * (1.f / DM) + EPS);
#pragma unroll
        for (int j = 0; j < 4; ++j) { const f32x4 gg = *((const f32x4*)gnext + lane + 64 * j); const f32x4 h = x[j] * r2 * gg;
            u32x2 w; w.x = pk2(h[0], h[1]); w.y = pk2(h[2], h[3]); *((u32x2*)hrow + lane + 64 * j) = w;
            if (h8row) *((unsigned*)h8row + lane + 64 * j) = pk4_fp8(h[0], h[1], h[2], h[3]); }
    }
}

constexpr int LP = 136;
template <bool CAUSAL>
__device__ __forceinline__ void mm128(const bf16_t* Pl, const bf16_t* Ql, int w, int r, int q, f32x4 (&acc)[8]) {
#pragma unroll
    for (int rb = 0; rb < 8; ++rb) acc[rb] = (f32x4){0.f, 0.f, 0.f, 0.f};
#pragma unroll
    for (int kb = 0; kb < 4; ++kb) {
        const bf16x8 p = *(const bf16x8*)(Pl + (16 * w + r) * LP + 32 * kb + 8 * q);
#pragma unroll
        for (int rb = 0; rb < 8; ++rb) {
            if (CAUSAL && rb < 2 * kb) continue;
            const bf16x8 qq = *(const bf16x8*)(Ql + (16 * rb + r) * LP + 32 * kb + 8 * q);
            acc[rb] = __builtin_amdgcn_mfma_f32_16x16x32_bf16(p, qq, acc[rb], 0, 0, 0);
        }
    }
}
__device__ __forceinline__ void unpack8(const u32x4 raw, float (&x)[8]) { x[0] = bflo(raw.x); x[1] = bfhi(raw.x); x[2] = bflo(raw.y); x[3] = bfhi(raw.y); x[4] = bflo(raw.z); x[5] = bfhi(raw.z); x[6] = bflo(raw.w); x[7] = bfhi(raw.w); }
__device__ __forceinline__ void gmlp_unit(const Ctx& C, int unit, bf16_t* ZA, const float* ln_g, const float* ln_b, const float* w_s, const float* b_s) {
    const int g = unit & 3, bc = unit >> 2; const size_t row0 = (size_t)bc * 128;
    float* stats = (float*)C.lds;
    bf16_t* vnT = (bf16_t*)(C.lds + 1024);
    bf16_t* wsL = (bf16_t*)(C.lds + 1024 + 128 * LP * 2);
    float* part = (float*)(C.lds + 1024 + 2 * 128 * LP * 2);
    const int w = C.wave, lane = C.lane, r = lane & 15, q = lane >> 4;
    u32x4 raw[2][8], fv[2][2]; u32x2 uw[8]; float bs[8];
#pragma unroll
    for (int h = 0; h < 2; ++h) { const int s = lane + 64 * h; const u32x4* vp = (const u32x4*)(ZA + (row0 + s) * 1024 + 512 + 64 * w);
#pragma unroll
        for (int k = 0; k < 8; ++k) raw[h][k] = vp[k];
        const u32x4* fp = (const u32x4*)(ZA + (row0 + s) * 1024 + 512 + g * 128 + 16 * w); fv[h][0] = fp[0]; fv[h][1] = fp[1]; }
#pragma unroll
    for (int tb = 0; tb < 8; ++tb) { const int t = 16 * tb + r; bs[tb] = b_s[g * 128 + t]; uw[tb] = *(const u32x2*)(ZA + (row0 + t) * 1024 + g * 128 + 16 * w + 4 * q); }
#pragma unroll
    for (int h = 0; h < 2; ++h) { const int s = lane + 64 * h;
        float s1 = 0.f, s2 = 0.f;
#pragma unroll
        for (int k = 0; k < 8; ++k) { float x[8]; unpack8(raw[h][k], x);
#pragma unroll
            for (int e = 0; e < 8; ++e) { s1 += x[e]; s2 += x[e] * x[e]; } }
        *(f32x2*)(part + (w * 128 + s) * 2) = (f32x2){s1, s2}; }
#pragma unroll
    for (int j = 0; j < 8; ++j) { const int idx = C.tid * 4 + 2048 * j, t = idx >> 7, s = idx & 127; const f32x4 v = *(const f32x4*)(w_s + (size_t)g * 128 * 128 + idx);
        u32x2 o; o.x = pk2(s <= t ? v[0] : 0.f, s + 1 <= t ? v[1] : 0.f); o.y = pk2(s + 2 <= t ? v[2] : 0.f, s + 3 <= t ? v[3] : 0.f);
        *(u32x2*)(wsL + t * LP + s) = o; }
    __syncthreads();
    if (C.tid < 128) { float s1 = 0.f, s2 = 0.f;
#pragma unroll
        for (int k = 0; k < 8; ++k) { const f32x2 p = *(const f32x2*)(part + (k * 128 + C.tid) * 2); s1 += p[0]; s2 += p[1]; }
        const float mean = s1 * (1.f / 512.f), var = fmaxf(s2 * (1.f / 512.f) - mean * mean, 0.f);
        *(f32x2*)(stats + 2 * C.tid) = (f32x2){mean, 1.0f / sqrtf(var + EPS)}; }
    __syncthreads();
    f32x4 gm[4], bt[4];
#pragma unroll
    for (int k = 0; k < 4; ++k) { gm[k] = *(const f32x4*)(ln_g + g * 128 + 16 * w + 4 * k); bt[k] = *(const f32x4*)(ln_b + g * 128 + 16 * w + 4 * k); }
#pragma unroll
    for (int h = 0; h < 2; ++h) { const int s = lane + 64 * h; const f32x2 st = *(const f32x2*)(stats + 2 * s);
        float x[16]; { float a[8], b[8]; unpack8(fv[h][0], a); unpack8(fv[h][1], b);
#pragma unroll
            for (int e = 0; e < 8; ++e) { x[e] = a[e]; x[8 + e] = b[e]; } }
#pragma unroll
        for (int j = 0; j < 16; ++j) vnT[(16 * w + j) * LP + s] = (bf16_t)f2bf((x[j] - st[0]) * st[1] * gm[j >> 2][j & 3] + bt[j >> 2][j & 3]); }
    __syncthreads();
    f32x4 acc[8];
    mm128<true>(vnT, wsL, w, r, q, acc);
#pragma unroll
    for (int tb = 0; tb < 8; ++tb) { const int t = 16 * tb + r;
        u32x2 o; o.x = pk2(bflo(uw[tb].x) * (acc[tb][0] + bs[tb]), bfhi(uw[tb].x) * (acc[tb][1] + bs[tb])); o.y = pk2(bflo(uw[tb].y) * (acc[tb][2] + bs[tb]), bfhi(uw[tb].y) * (acc[tb][3] + bs[tb]));
        *(u32x2*)(ZA + (row0 + t) * 1024 + g * 128 + 16 * w + 4 * q) = o; }
    __syncthreads();
}
template <int W>
__device__ __forceinline__ void pool_fill(const bf16_t* ZCg, int row0, int tid, bf16_t* pl) {
    const int c8 = tid & 15, s0 = 4 * (tid >> 4); const int rowb = row0 + s0, t0 = rowb & (SEQ - 1);
    u32x4 raw[W + 3];
#pragma unroll
    for (int k = 0; k < W + 3; ++k) { const int dt = k - (W - 1);
        raw[k] = (t0 + dt >= 0) ? *(const u32x4*)(ZCg + (size_t)(rowb + dt) * 512 + 8 * c8) : (u32x4){0u, 0u, 0u, 0u}; }
    float sum[8] = {0.f, 0.f, 0.f, 0.f, 0.f, 0.f, 0.f, 0.f};
#pragma unroll
    for (int k = 0; k < W; ++k) { float x[8]; unpack8(raw[k], x);
#pragma unroll
        for (int e = 0; e < 8; ++e) sum[e] += x[e]; }
#pragma unroll
    for (int j = 0; j < 4; ++j) { float self[8]; unpack8(raw[j + W - 1], self);
        if (j > 0) { float old[8]; unpack8(raw[j - 1], old);
#pragma unroll
            for (int e = 0; e < 8; ++e) sum[e] += self[e] - old[e]; }
        const int cnt = (t0 + j + 1 < W) ? t0 + j + 1 : W; const float inv = 1.0f / (float)cnt;
        u32x4 o; o.x = pk2(sum[0] * inv - self[0], sum[1] * inv - self[1]); o.y = pk2(sum[2] * inv - self[2], sum[3] * inv - self[3]);
        o.z = pk2(sum[4] * inv - self[4], sum[5] * inv - self[5]); o.w = pk2(sum[6] * inv - self[6], sum[7] * inv - self[7]);
        *(u32x4*)(pl + (s0 + j) * LP + 8 * c8) = o; }
}
__device__ __forceinline__ void pool_unit(const Ctx& C, int unit, const bf16_t* ZC, const bf16_t* WpT, const float* pool_scale, bf16_t* YC) {
    const int g = unit & 3, tile = unit >> 2; const int row0 = tile * 128;
    bf16_t* pl = (bf16_t*)(C.lds + 1024);
    bf16_t* wl = (bf16_t*)(C.lds + 1024 + 128 * LP * 2);
    const int w = C.wave, lane = C.lane;
    if (g == 0) pool_fill<2>(ZC + g * 128, row0, C.tid, pl); else if (g == 1) pool_fill<4>(ZC + g * 128, row0, C.tid, pl);
    else if (g == 2) pool_fill<8>(ZC + g * 128, row0, C.tid, pl); else pool_fill<16>(ZC + g * 128, row0, C.tid, pl);
#pragma unroll
    for (int j = 0; j < 4; ++j) { const int idx = C.tid + 512 * j, d = idx >> 4, c16 = idx & 15;
        *(u32x4*)(wl + d * LP + 8 * c16) = *(const u32x4*)(WpT + (size_t)g * 128 * 128 + d * 128 + 8 * c16); }
    __syncthreads();
    const int r = lane & 15, q = lane >> 4;
    f32x4 acc[8];
    mm128<false>(wl, pl, w, r, q, acc);
    const f32x4 ps = *(const f32x4*)(pool_scale + g * 128 + 16 * w + 4 * q);
#pragma unroll
    for (int sb = 0; sb < 8; ++sb) { const int s = 16 * sb + r;
        u32x2 o; o.x = pk2(acc[sb][0] * ps[0], acc[sb][1] * ps[1]); o.y = pk2(acc[sb][2] * ps[2], acc[sb][3] * ps[3]);
        *(u32x2*)(YC + (size_t)(row0 + s) * 1024 + 512 + g * 128 + 16 * w + 4 * q) = o; }
    __syncthreads();
}
namespace attn_body {
using bf16=unsigned short;
using s16x4=__attribute__((ext_vector_type(4)))short;
using f32x16=__attribute__((ext_vector_type(16)))float;
constexpr int BATCH=8,SEQ=2048,D=64,DM=1536;
constexpr int NW=8,QBLK=32,QB=QBLK*NW,KVBLK=64,NQB=SEQ/QB;
__device__ __forceinline__ int crow(int r,int hi){return (r&3)+8*(r>>2)+4*hi;}
#define SBAR() __builtin_amdgcn_sched_barrier(0)
__device__ __forceinline__ void cmask(f32x16&p0,f32x16&p1,int jb,int qrel,int hi){
  const float NEG=-INFINITY; int kb=64*jb+4*hi;
  #pragma unroll
  for(int r=0;r<16;++r){int kv=kb+(r&3)+8*(r>>2); if(kv>qrel)p0[r]=NEG; if(kv+32>qrel)p1[r]=NEG;}
}

constexpr int NSLOT=3, SLOTB=8192;
constexpr int LDS_K=0, LDS_V=NSLOT*SLOTB, LDS_WS=2*NSLOT*SLOTB, LDS_OST=LDS_WS+NW*64*4, LDS_BYTES=LDS_OST+NW*8192;
constexpr float C2=0.125f*1.4426950408889634f;
__device__ __forceinline__ void glds16(const void*gsrc,unsigned lds_dst){unsigned keep;
  asm volatile("s_mov_b32 %0, m0\n\ts_mov_b32 m0, %2\n\ts_nop 0\n\tglobal_load_lds_dwordx4 %1, off\n\ts_mov_b32 m0, %0":"=&s"(keep):"v"(gsrc),"s"(lds_dst):"memory");}
__device__ __forceinline__ float max3f(float a,float b,float c){float r;asm("v_max3_f32 %0, %1, %2, %3":"=v"(r):"v"(a),"v"(b),"v"(c));return r;}
__device__ __forceinline__ float max2f(float a,float b){float r;asm("v_max_f32_e32 %0, %1, %2":"=v"(r):"v"(a),"v"(b));return r;}
__device__ __forceinline__ float fadd_s(float a,float b){float r;asm("v_add_f32_e32 %0, %1, %2":"=v"(r):"v"(a),"v"(b));return r;}
__device__ __forceinline__ float fsub_s(float a,float b){float r;asm("v_sub_f32_e32 %0, %1, %2":"=v"(r):"v"(a),"v"(b));return r;}
typedef float f32x2_t __attribute__((ext_vector_type(2))); typedef __bf16 bf16x2_t __attribute__((ext_vector_type(2)));
__device__ __forceinline__ unsigned cvtpk_s(float lo,float hi){f32x2_t v={lo,hi};bf16x2_t b=__builtin_convertvector(v,bf16x2_t);return __builtin_bit_cast(unsigned,b);}
#define WAIT_BAR(N) asm volatile("s_waitcnt vmcnt(" #N ") lgkmcnt(0)\n\ts_barrier":::"memory")

__device__ __forceinline__ void qkt(f32x16&p0,f32x16&p1,const char*Kslot,const bf16x8*qr,const f32x16&negm,int r32,int hi){
  const char*kb=Kslot+hi*1024+r32*16;
  #pragma unroll
  for(int d0=0;d0<4;++d0){
    const bf16x8 b0=*reinterpret_cast<const bf16x8*>(kb+d0*2048);
    const bf16x8 b1=*reinterpret_cast<const bf16x8*>(kb+d0*2048+512);
    if(d0==0){p0=__builtin_amdgcn_mfma_f32_32x32x16_bf16(b0,qr[0],negm,0,0,0);p1=__builtin_amdgcn_mfma_f32_32x32x16_bf16(b1,qr[0],negm,0,0,0);}
    else{p0=__builtin_amdgcn_mfma_f32_32x32x16_bf16(b0,qr[d0],p0,0,0,0);p1=__builtin_amdgcn_mfma_f32_32x32x16_bf16(b1,qr[d0],p1,0,0,0);}}
}
typedef __attribute__((address_space(3))) const char* lds_cptr;
typedef short v4i16_t __attribute__((ext_vector_type(4)));
__device__ __forceinline__ void kload8(bf16x8*kf,lds_cptr kp){
  kf[0]=*(const __attribute__((address_space(3))) bf16x8*)(kp);      kf[1]=*(const __attribute__((address_space(3))) bf16x8*)(kp+512);
  kf[2]=*(const __attribute__((address_space(3))) bf16x8*)(kp+2048); kf[3]=*(const __attribute__((address_space(3))) bf16x8*)(kp+2560);
  kf[4]=*(const __attribute__((address_space(3))) bf16x8*)(kp+4096); kf[5]=*(const __attribute__((address_space(3))) bf16x8*)(kp+4608);
  kf[6]=*(const __attribute__((address_space(3))) bf16x8*)(kp+6144); kf[7]=*(const __attribute__((address_space(3))) bf16x8*)(kp+6656);
}
__device__ __forceinline__ void kload2(bf16x8*kf,lds_cptr kp,int j){ kf[2*j]=*(const __attribute__((address_space(3))) bf16x8*)(kp+j*2048); kf[2*j+1]=*(const __attribute__((address_space(3))) bf16x8*)(kp+j*2048+512); }
__device__ __forceinline__ s16x4 vtr(lds_cptr p){ return __builtin_bit_cast(s16x4,__builtin_amdgcn_ds_read_tr16_b64_v4i16((__attribute__((address_space(3))) v4i16_t*)p)); }
__device__ __forceinline__ float rowmax(const f32x16&p0,const f32x16&p1){
  float a=max3f(p0[0],p0[1],p1[0]),b=max3f(p0[2],p0[3],p1[1]);a=max3f(a,p1[2],p1[3]);
  #pragma unroll
  for(int r=4;r<16;r+=4){a=max3f(a,p0[r],p0[r+1]);b=max3f(b,p0[r+2],p0[r+3]);a=max3f(a,p1[r],p1[r+1]);b=max3f(b,p1[r+2],p1[r+3]);}
  const float m=max2f(a,b);
  auto rr=__builtin_amdgcn_permlane32_swap(__float_as_uint(m),__float_as_uint(m),false,false);
  return max2f(__uint_as_float(rr[0]),__uint_as_float(rr[1]));
}
__device__ __forceinline__ void pv(f32x16*o,int vb,bf16x8 pa0,bf16x8 pa1,bf16x8 pa2,bf16x8 pa3){
  #pragma unroll
  for(int d0=0;d0<2;++d0){s16x4 lo[4],hi[4];
    #pragma unroll
    for(int ks=0;ks<4;++ks){
      asm volatile("ds_read_b64_tr_b16 %0,%1 offset:%c2":"=&v"(lo[ks]):"v"(vb),"i"(d0*4096+ks*1024):"memory");
      asm volatile("ds_read_b64_tr_b16 %0,%1 offset:%c2":"=&v"(hi[ks]):"v"(vb),"i"(d0*4096+ks*1024+512):"memory");}
    asm volatile("s_waitcnt lgkmcnt(0)":::"memory");SBAR();
    #define PK(k) (bf16x8){lo[k][0],lo[k][1],lo[k][2],lo[k][3],hi[k][0],hi[k][1],hi[k][2],hi[k][3]}
    o[d0]=__builtin_amdgcn_mfma_f32_32x32x16_bf16(pa0,PK(0),o[d0],0,0,0);
    o[d0]=__builtin_amdgcn_mfma_f32_32x32x16_bf16(pa1,PK(1),o[d0],0,0,0);
    o[d0]=__builtin_amdgcn_mfma_f32_32x32x16_bf16(pa2,PK(2),o[d0],0,0,0);
    o[d0]=__builtin_amdgcn_mfma_f32_32x32x16_bf16(pa3,PK(3),o[d0],0,0,0);
    #undef PK
  }
}

#ifndef ATTN_STORE16
#define ATTN_STORE16(p,v) (*(u32x4*)(p)=(v))
#endif
template<int THRL> __device__ __forceinline__ void attn_unit(int b,int qb,const bf16*Q,const bf16*__restrict__ K,const bf16*__restrict__ V,int c,int vh,float lam,char*shm,int wave_){
  const int tid=fresh_tid(wave_),lane=tid&63,r32=lane&31,hi=lane>>5; const int wid=__builtin_amdgcn_readfirstlane(tid>>6);
  const long rowbase=(long)b*SEQ; const int q0=qb*QB;
  const bf16*Qw=Q+(rowbase+q0+wid*QBLK)*DM;
  const bf16*Kh=K+rowbase*DM,*Vh=V+rowbase*DM;
  const unsigned lds0=(unsigned)(uintptr_t)shm;
  float*wsf=(float*)(shm+LDS_WS)+wid*64;
  const bf16*ksrc=Kh+(long)lane*DM+wid*8;
  const bf16*vsrc=Vh+(long)(16*(wid&3)+(lane>>2))*DM+(wid>>2)*32+(lane&3)*8;
  const unsigned kdst=lds0+LDS_K+wid*1024, vdst=lds0+LDS_V+wid*1024;
  #define DMA_K(t,slot) glds16(ksrc+(long)(t)*KVBLK*DM,(unsigned)__builtin_amdgcn_readfirstlane(kdst+(slot)))
  #define DMA_V(t,slot) glds16(vsrc+(long)(t)*KVBLK*DM,(unsigned)__builtin_amdgcn_readfirstlane(vdst+(slot)))
  const int vb0=(int)(lds0+LDS_V)+((lane>>4)&1)*32+(lane&3)*8+(4*hi+((lane&15)>>2))*64;
  const char*Kbase=shm+LDS_K; bf16x8 kf[8];
  const lds_cptr shm3=(lds_cptr)shm; const lds_cptr kp0=shm3+LDS_K+hi*1024+r32*16; const lds_cptr vp0=shm3+LDS_V+((lane>>4)&1)*32+(lane&3)*8+(4*hi+((lane&15)>>2))*64;
  const int NT=(q0+QB)/KVBLK;
  DMA_K(0,0);DMA_V(0,0);DMA_K(1,SLOTB);
  bf16x8 qr[4];
  #pragma unroll
  for(int d0=0;d0<4;++d0)qr[d0]=*reinterpret_cast<const bf16x8*>(&Qw[(long)r32*DM+d0*16+hi*8]);
  float mhat=0.f,l_reg=0.f;f32x16 o[2];o[0]=f32x16{};o[1]=f32x16{};f32x16 negm=f32x16{};asm volatile("":"+v"(negm));
  const int qrel=wid*QBLK+r32;
  #define CMASK(P0,P1,t) do{int jb_=(t)-(NT-4); if(jb_>=0)cmask(P0,P1,jb_,qrel,hi);}while(0)
  bool resc=false;
  #define START(P0,P1) do{ const float rm=rowmax(P0,P1); resc=false; \
    { const float dl=rm; mhat=fadd_s(mhat,dl); \
      _Pragma("unroll") for(int r=0;r<16;++r){P0[r]=fsub_s(P0[r],dl);P1[r]=fsub_s(P1[r],dl);} \
      _Pragma("unroll") for(int r=0;r<16;++r)negm[r]=-mhat; asm volatile("":"+v"(negm)); } \
    _Pragma("unroll") for(int r=0;r<16;++r)P0[r]=__builtin_amdgcn_exp2f(P0[r]); }while(0)
  #define RESC() do{ if(resc){ asm volatile("s_waitcnt lgkmcnt(0)":::"memory"); \
      _Pragma("unroll") for(int d_=0;d_<2;++d_) _Pragma("unroll") for(int r=0;r<16;++r)o[d_][r]*=wsf[crow(r,hi)]; } }while(0)
  f32x16 pA0,pA1,pB0,pB1;
  int sl_prev=0,sl_cur=0,sl_next=SLOTB;
  #define ROT() do{sl_prev=sl_cur;sl_cur=sl_next;sl_next=(sl_next==(NSLOT-1)*SLOTB)?0:sl_next+SLOTB;}while(0)
  DMA_K(2,2*SLOTB);
  WAIT_BAR(3);
  qkt(pA0,pA1,Kbase,qr,negm,r32,hi);asm volatile("s_nop 15\n\ts_nop 7":"+v"(pA0),"+v"(pA1));CMASK(pA0,pA1,0);
  START(pA0,pA1);
  _Pragma("unroll") for(int r=0;r<16;++r)pA1[r]=__builtin_amdgcn_exp2f(pA1[r]);
  WAIT_BAR(0);
  DMA_K(3,0);DMA_V(1,SLOTB);
  ROT();
  kload8(kf,kp0+sl_cur);
  WAIT_BAR(2);
  s16x4 vlo[8],vhi[8]; u32x4 pw0,pw1,pw2,pw3;
  #define PKW(P,B) cvtpk_s(P[B],P[B+1])
  #define PAF(k) __builtin_bit_cast(bf16x8,pw##k)
  #define VFR(i) (bf16x8){vlo[i][0],vlo[i][1],vlo[i][2],vlo[i][3],vhi[i][0],vhi[i][1],vhi[i][2],vhi[i][3]}
  #define PIN(x) asm volatile("":"+v"(x))
  #define MX3(a,b,c) __builtin_fmaxf(__builtin_fmaxf((a),(b)),(c))
  #define GAPA(MF,A0,A1,A2,A3,W0,W1,PW) do{ MF; sacc+=A0; sacc+=A1; sacc+=A2; sacc+=A3; PIN(sacc); W0; W1; PIN(PW); SBAR(); }while(0)
  #define EX(v) __builtin_amdgcn_exp2f(v)
  #define GAPB(MF,X,B) do{ MF; X[B]=EX(X[B]); X[B+1]=EX(X[B+1]); X[B+2]=EX(X[B+2]); X[B+3]=EX(X[B+3]); PIN(X); SBAR(); }while(0)
  #define VRD(i) do{ vlo[i]=vtr(vp_+(((i)>>2)*4096+((i)&3)*1024)); vhi[i]=vtr(vp_+(((i)>>2)*4096+((i)&3)*1024+512)); }while(0)
  #define KRD(G,j) do{ if(G){ kload2(kf,kp0+sl_next,j); SBAR(); } }while(0)
  #define STEP(C0,C1,P0,P1,t,GK,GV,GL) do{ SBAR(); \
    const lds_cptr vp_=vp0+sl_prev; \
    VRD(0); SBAR(); float sacc=(P0[0]+P0[1]); \
    GAPA(C0=__builtin_amdgcn_mfma_f32_32x32x16_bf16(kf[0],qr[0],negm,0,0,0), P0[2],P0[3],P0[4],P0[5],     pw0[0]=PKW(P0,0), pw0[1]=PKW(P0,2), pw0); \
    VRD(4); SBAR(); GAPA(C1=__builtin_amdgcn_mfma_f32_32x32x16_bf16(kf[1],qr[0],negm,0,0,0), P0[6],P0[7],P0[8],P0[9],     pw0[2]=PKW(P0,4), pw0[3]=PKW(P0,6), pw0); \
    VRD(1); SBAR(); GAPA(C0=__builtin_amdgcn_mfma_f32_32x32x16_bf16(kf[2],qr[1],C0,0,0,0),   P0[10],P0[11],P0[12],P0[13], pw1[0]=PKW(P0,8), pw1[1]=PKW(P0,10), pw1); \
    VRD(5); SBAR(); GAPA(C1=__builtin_amdgcn_mfma_f32_32x32x16_bf16(kf[3],qr[1],C1,0,0,0),   P0[14],P0[15],P1[0],P1[1],   pw1[2]=PKW(P0,12),pw1[3]=PKW(P0,14), pw1); \
    VRD(2); SBAR(); GAPA(C0=__builtin_amdgcn_mfma_f32_32x32x16_bf16(kf[4],qr[2],C0,0,0,0),   P1[2],P1[3],P1[4],P1[5],     pw2[0]=PKW(P1,0), pw2[1]=PKW(P1,2), pw2); \
    VRD(6); SBAR(); GAPA(C1=__builtin_amdgcn_mfma_f32_32x32x16_bf16(kf[5],qr[2],C1,0,0,0),   P1[6],P1[7],P1[8],P1[9],     pw2[2]=PKW(P1,4), pw2[3]=PKW(P1,6), pw2); \
    VRD(3); SBAR(); GAPA(C0=__builtin_amdgcn_mfma_f32_32x32x16_bf16(kf[6],qr[3],C0,0,0,0),   P1[10],P1[11],P1[12],P1[13], pw3[0]=PKW(P1,8), pw3[1]=PKW(P1,10), pw3); \
    VRD(7); SBAR(); GAPA(C1=__builtin_amdgcn_mfma_f32_32x32x16_bf16(kf[7],qr[3],C1,0,0,0),   P1[14],P1[15],0.f,0.f,       pw3[2]=PKW(P1,12),pw3[3]=PKW(P1,14), pw3); \
    l_reg+=sacc; \
    if(GK){DMA_K((t)+3,sl_cur);} if(GV){DMA_V((t)+1,sl_next);} \
    CMASK(C0,C1,t); \
    { float a=MX3(C0[0],C0[1],C1[0]),b=MX3(C0[2],C0[3],C1[1]); a=MX3(a,C1[2],C1[3]); \
      _Pragma("unroll") for(int r=4;r<16;r+=4){a=MX3(a,C0[r],C0[r+1]);b=MX3(b,C0[r+2],C0[r+3]);a=MX3(a,C1[r],C1[r+1]);b=MX3(b,C1[r+2],C1[r+3]);} \
      float rm=__builtin_fmaxf(a,b); { auto rr=__builtin_amdgcn_permlane32_swap(__float_as_uint(rm),__float_as_uint(rm),false,false); rm=__builtin_fmaxf(__uint_as_float(rr[0]),__uint_as_float(rr[1])); } \
      resc=false; \
      if(__builtin_expect(__any(rm>(float)THRL),0)){ const float dl=__builtin_fmaxf(rm,0.f); mhat+=dl; \
        _Pragma("unroll") for(int r=0;r<16;++r){C0[r]-=dl;C1[r]-=dl;} \
        _Pragma("unroll") for(int r=0;r<16;++r)negm[r]=-mhat; asm volatile("":"+v"(negm)); \
        const float f=__builtin_amdgcn_exp2f(-dl); l_reg*=f; if(hi==0)wsf[r32]=f; resc=true; } } \
    SBAR(); \
    GAPB(o[0]=__builtin_amdgcn_mfma_f32_32x32x16_bf16(PAF(0),VFR(0),o[0],0,0,0), C0,0); \
    GAPB(o[1]=__builtin_amdgcn_mfma_f32_32x32x16_bf16(PAF(0),VFR(4),o[1],0,0,0), C0,4); \
    KRD(GL,0); GAPB(o[0]=__builtin_amdgcn_mfma_f32_32x32x16_bf16(PAF(1),VFR(1),o[0],0,0,0), C0,8); \
    KRD(GL,1); GAPB(o[1]=__builtin_amdgcn_mfma_f32_32x32x16_bf16(PAF(1),VFR(5),o[1],0,0,0), C0,12); \
    KRD(GL,2); GAPB(o[0]=__builtin_amdgcn_mfma_f32_32x32x16_bf16(PAF(2),VFR(2),o[0],0,0,0), C1,0); \
    KRD(GL,3); GAPB(o[1]=__builtin_amdgcn_mfma_f32_32x32x16_bf16(PAF(2),VFR(6),o[1],0,0,0), C1,4); \
    GAPB(o[0]=__builtin_amdgcn_mfma_f32_32x32x16_bf16(PAF(3),VFR(3),o[0],0,0,0), C1,8); \
    GAPB(o[1]=__builtin_amdgcn_mfma_f32_32x32x16_bf16(PAF(3),VFR(7),o[1],0,0,0), C1,12); \
    }while(0)
  int t=1;
  #undef CMASK
  #define CMASK(P0,P1,t) do{}while(0)
  for(;t+5<NT;t+=2){
    STEP(pB0,pB1,pA0,pA1,t,true,true,true);     WAIT_BAR(2); RESC(); ROT();
    STEP(pA0,pA1,pB0,pB1,t+1,true,true,true);   WAIT_BAR(2); RESC(); ROT();
  }
  #undef CMASK
  #define CMASK(P0,P1,t) do{int jb_=(t)-(NT-4); if(jb_>=0)cmask(P0,P1,jb_,qrel,hi);}while(0)
  #define ENDW(tt) do{ if((tt)+3<NT){WAIT_BAR(2);} else if((tt)+2<NT){WAIT_BAR(1);} else {WAIT_BAR(0);} }while(0)
  for(;t+1<NT;t+=2){
    STEP(pB0,pB1,pA0,pA1,t,(t+3<NT),(t+1<NT),(t+1<NT));       ENDW(t);   RESC(); ROT();
    STEP(pA0,pA1,pB0,pB1,t+1,(t+4<NT),(t+2<NT),(t+2<NT));     ENDW(t+1); RESC(); ROT();
  }
  STEP(pB0,pB1,pA0,pA1,NT-1,false,false,false); RESC();
  { float sacc=pB0[0]+pB0[1]; _Pragma("unroll") for(int r=2;r<16;++r)sacc+=pB0[r]; _Pragma("unroll") for(int r=0;r<16;++r)sacc+=pB1[r]; l_reg+=sacc;
    pw0=(u32x4){PKW(pB0,0),PKW(pB0,2),PKW(pB0,4),PKW(pB0,6)};pw1=(u32x4){PKW(pB0,8),PKW(pB0,10),PKW(pB0,12),PKW(pB0,14)};pw2=(u32x4){PKW(pB1,0),PKW(pB1,2),PKW(pB1,4),PKW(pB1,6)};pw3=(u32x4){PKW(pB1,8),PKW(pB1,10),PKW(pB1,12),PKW(pB1,14)};
    SBAR(); pv(o,vb0+sl_cur,PAF(0),PAF(1),PAF(2),PAF(3)); }
  #undef PKW
  #undef PAF
  #undef VFR
  #undef PIN
  #undef MX3
  #undef GAPA
  #undef GAPB
  #undef EX
  #undef VRD
  #undef KRD
  #undef STEP
  #undef ENDW
  {auto rr=__builtin_amdgcn_permlane32_swap(__float_as_uint(l_reg),__float_as_uint(l_reg),false,false);l_reg=__uint_as_float(rr[0])+__uint_as_float(rr[1]);}
  if(hi==0)wsf[32+r32]=l_reg;asm volatile("s_waitcnt lgkmcnt(0)":::"memory");
  float rli[16];
  #pragma unroll
  for(int r=0;r<16;++r)rli[r]=__builtin_amdgcn_rcpf(wsf[32+crow(r,hi)]);
  { bf16*stg=(bf16*)(shm+LDS_OST)+wid*4096;
    if(c==0){
      #pragma unroll
      for(int r=0;r<16;++r){const int orow=crow(r,hi);
        #pragma unroll
        for(int d0=0;d0<2;++d0)stg[orow*128+vh*64+d0*32+r32]=(bf16)f2bf(o[d0][r]*rli[r]);}
    } else {
      #pragma unroll
      for(int r=0;r<16;++r){const int orow=crow(r,hi);
        #pragma unroll
        for(int d0=0;d0<2;++d0){bf16*p=stg+orow*128+vh*64+d0*32+r32; const float prev=__uint_as_float(((unsigned)*p)<<16); *p=(bf16)f2bf(prev-lam*(o[d0][r]*rli[r]));}}
    } }
  asm volatile("s_waitcnt lgkmcnt(0)\n\ts_barrier":::"memory");
  #undef DMA_K
  #undef DMA_V
  #undef CMASK
  #undef START
  #undef RESC
  #undef ROT
}
__device__ __forceinline__ void attn_finish(int b,int h,int qb,bf16*YB,const float*g,float out_scale,char*shm,int wave_){
  const int tid_=fresh_tid(wave_); const int lane=tid_&63; const int wid=__builtin_amdgcn_readfirstlane(tid_>>6);
  asm volatile("s_waitcnt lgkmcnt(0)":::"memory");
  const bf16*stg=(const bf16*)(shm+LDS_OST)+wid*4096; const int ch=lane&15;
  const f32x4 g0=*(const f32x4*)(g+ch*8),g1=*(const f32x4*)(g+ch*8+4);
  const size_t rowb=(size_t)b*SEQ+(size_t)qb*QB+wid*QBLK;
  #pragma unroll
  for(int i=0;i<8;++i){const int row=i*4+(lane>>4);
    const u32x4 v=*(const u32x4*)(stg+row*128+ch*8);
    const float x0=bflo(v.x),x1=bfhi(v.x),x2=bflo(v.y),x3=bfhi(v.y),x4=bflo(v.z),x5=bfhi(v.z),x6=bflo(v.w),x7=bfhi(v.w);
    float ss=(x0*x0+x1*x1)+(x2*x2+x3*x3)+(x4*x4+x5*x5)+(x6*x6+x7*x7);
    ss+=__shfl_xor(ss,1);ss+=__shfl_xor(ss,2);ss+=__shfl_xor(ss,4);ss+=__shfl_xor(ss,8);
    const float rs=out_scale/sqrtf(ss*(1.f/128.f)+EPS);
    u32x4 o;o.x=pk2(x0*rs*g0[0],x1*rs*g0[1]);o.y=pk2(x2*rs*g0[2],x3*rs*g0[3]);o.z=pk2(x4*rs*g1[0],x5*rs*g1[1]);o.w=pk2(x6*rs*g1[2],x7*rs*g1[3]);
    *(u32x4*)(YB+(rowb+row)*1024+h*128+ch*8)=o;}
  asm volatile("s_waitcnt lgkmcnt(0)":::"memory");
}
__device__ __forceinline__ void attn_finish_half(int b,int h,int qb,int vh,bf16*YB,const float*g,float out_scale,unsigned long long*xh,char*shm,int wave_){
  const int tid_=fresh_tid(wave_); const int lane=tid_&63; const int wid=__builtin_amdgcn_readfirstlane(tid_>>6);
  asm volatile("s_waitcnt lgkmcnt(0)":::"memory");
  const bf16*stg=(const bf16*)(shm+LDS_OST)+wid*4096; const int ch=lane&7;
  float x[4][8],ss[4];
  #pragma unroll
  for(int i=0;i<4;++i){const int row=i*8+(lane>>3);
    unpack8(*(const u32x4*)(stg+row*128+vh*64+ch*8),x[i]);
    float q=0.f;
    #pragma unroll
    for(int e=0;e<8;++e)q+=x[i][e]*x[i][e];
    q+=__shfl_xor(q,1);q+=__shfl_xor(q,2);q+=__shfl_xor(q,4);ss[i]=q;
    if(ch==0)__hip_atomic_store(xh+vh*256+wid*32+row,(1ull<<32)|(unsigned long long)__float_as_uint(q),__ATOMIC_RELAXED,__HIP_MEMORY_SCOPE_AGENT);}
  const f32x4 g0=*(const f32x4*)(g+vh*64+ch*8),g1=*(const f32x4*)(g+vh*64+ch*8+4);
  const size_t rowb=(size_t)b*SEQ+(size_t)qb*QB+wid*QBLK;
  #pragma unroll
  for(int i=0;i<4;++i){const int row=i*8+(lane>>3);
    unsigned long long pv=0ull;
    #pragma unroll 1
    for(unsigned it=0;it<(1u<<20);++it){pv=__hip_atomic_load(xh+(vh^1)*256+wid*32+row,__ATOMIC_RELAXED,__HIP_MEMORY_SCOPE_AGENT); if((pv>>32)!=0ull)break; __builtin_amdgcn_s_sleep(1);}
    const float tot=ss[i]+__uint_as_float((unsigned)pv);
    const float rs=out_scale/sqrtf(tot*(1.f/128.f)+EPS);
    u32x4 o;o.x=pk2(x[i][0]*rs*g0[0],x[i][1]*rs*g0[1]);o.y=pk2(x[i][2]*rs*g0[2],x[i][3]*rs*g0[3]);o.z=pk2(x[i][4]*rs*g1[0],x[i][5]*rs*g1[1]);o.w=pk2(x[i][6]*rs*g1[2],x[i][7]*rs*g1[3]);
    *(u32x4*)(YB+(rowb+row)*1024+h*128+vh*64+ch*8)=o;}
  asm volatile("s_waitcnt lgkmcnt(0)":::"memory");
}
constexpr int ATTN_LDS_BYTES=LDS_BYTES;
#undef SBAR
#undef WAIT_BAR
}

#define LAS __attribute__((address_space(3)))
constexpr size_t WS_CTL = 242 * MiB, CTL_ZERO_BYTES = 32768;
constexpr int LDSCTL_OFF = 131072, MISC_OFF = LDSCTL_OFF + 320;
#define XB_TMO      128
#define XB_XCNT(j)  (256  + 64 * (j))
#define XB_XSUB(j)  (1280 + 64 * (j))
#define XB_XGEN(j)  (2304 + 64 * (j))
#define XB_TOP      3328
#define XB_TOPGEN   3392
#define XCD_BAR_WORDS 3456
#define XB_SPIN_CAP (1u << 18)

__device__ __forceinline__ unsigned xb_ld(unsigned* p)              { return __hip_atomic_load(p, __ATOMIC_RELAXED, __HIP_MEMORY_SCOPE_AGENT); }
__device__ __forceinline__ unsigned xb_add(unsigned* p, unsigned v) { return __hip_atomic_fetch_add(p, v, __ATOMIC_RELAXED, __HIP_MEMORY_SCOPE_AGENT); }
__device__ __forceinline__ unsigned xb_xcc_id() { return (unsigned)__builtin_amdgcn_s_getreg((3 << 11) | 20) & 0xFu; }
#define XB_SPIN(cond, bar) do { unsigned _sp = 0; while (cond) { __builtin_amdgcn_s_sleep(1); \
    if ((++_sp & 255u) == 0u) { if (xb_ld(&(bar)[XB_TMO])) break; if (_sp > XB_SPIN_CAP) { atomicAdd(&(bar)[XB_TMO], 1u); break; } } } } while (0)

struct XcdBarrier {
    unsigned* bar; unsigned x;
    volatile LAS unsigned* st;
};

__device__ __forceinline__ XcdBarrier xcd_barrier_post(unsigned* bar, volatile LAS unsigned* st) {
    XcdBarrier b; b.bar = bar; b.x = xb_xcc_id(); b.st = st;
    if (threadIdx.x == 0) { st[3] = xb_add(&bar[XB_XCNT(b.x)], 1u); st[2] = blockIdx.x; }
    return b;
}
__device__ __forceinline__ void xcd_barrier_complete(unsigned* bar, unsigned x, unsigned& nloc, unsigned& nx) {
    const unsigned G = gridDim.x * gridDim.y * gridDim.z;
    unsigned sum, cnt, mine, sp = 0u;
    for (;;) {
        sum = 0u; cnt = 0u; mine = 0u;
#pragma unroll
        for (unsigned j = 0; j < 16; ++j) { const unsigned c = xb_ld(&bar[XB_XCNT(j)]); sum += c; cnt += (c > 0u) ? 1u : 0u; mine = (j == x) ? c : mine; }
        if (sum == G) break;
        __builtin_amdgcn_s_sleep(1);
        if ((++sp & 255u) == 0u) { if (xb_ld(&bar[XB_TMO])) break; if (sp > XB_SPIN_CAP) { atomicAdd(&bar[XB_TMO], 1u); break; } }
    }
    nloc = mine > 0u ? mine : 1u; nx = cnt > 0u ? cnt : 1u;
}

__device__ __forceinline__ void xcd_barrier(const XcdBarrier& b, bool thread0) {
    asm volatile("s_waitcnt vmcnt(0)" ::: "memory");
    __syncthreads();
    if (thread0) {
        unsigned* bar = b.bar;
        __builtin_amdgcn_s_waitcnt(0);
        unsigned nloc = b.st[0], nx = b.st[1];
        if (nloc == 0u) { xcd_barrier_complete(bar, b.x, nloc, nx); b.st[0] = nloc; b.st[1] = nx; }
        const unsigned old = xb_add(&bar[XB_XSUB(b.x)], 1u);
        const unsigned gen = old / nloc;
        if (old + 1u == (gen + 1u) * nloc) {
            __builtin_amdgcn_fence(__ATOMIC_RELEASE, "agent");
            asm volatile("s_waitcnt vmcnt(0)" ::: "memory");
            const unsigned og = xb_add(&bar[XB_TOP], 1u);
            const unsigned tg = og / nx;
            if (og + 1u == (tg + 1u) * nx) xb_add(&bar[XB_TOPGEN], 1u);
            else XB_SPIN(xb_ld(&bar[XB_TOPGEN]) == tg, bar);
            __builtin_amdgcn_fence(__ATOMIC_ACQUIRE, "agent");
            xb_add(&bar[XB_XGEN(b.x)], 1u);
            asm volatile("s_waitcnt vmcnt(0)" ::: "memory");
        } else {
            XB_SPIN(xb_ld(&bar[XB_XGEN(b.x)]) == gen, bar);
            __builtin_amdgcn_fence(__ATOMIC_ACQUIRE, "agent");
            asm volatile("s_waitcnt vmcnt(0)" ::: "memory");
        }
    }
    __syncthreads();
}

#define XB_XSUB2(j) (4096 + 64 * (j))
#define XB_XGEN2(j) (4608 + 64 * (j))
#define XB_TOP4 5184
#define XB_TOP3 5120
__device__ __forceinline__ void xcc_barrier(unsigned* bar, unsigned x, bool thread0, bool arrive_top, unsigned wait_top, int top_word) {
    asm volatile("s_waitcnt vmcnt(0)" ::: "memory");
    __syncthreads();
    if (thread0) {
        __builtin_amdgcn_s_waitcnt(0);
        const unsigned old = xb_add(&bar[XB_XSUB2(x)], 1u);
        const unsigned gen = old / 32u;
        if (old + 1u == (gen + 1u) * 32u) {
            __builtin_amdgcn_fence(__ATOMIC_RELEASE, "agent");
            asm volatile("s_waitcnt vmcnt(0)" ::: "memory");
            if (arrive_top) xb_add(&bar[top_word], 1u);
            if (wait_top != 0u) XB_SPIN(xb_ld(&bar[top_word]) < wait_top, bar);
            __builtin_amdgcn_fence(__ATOMIC_ACQUIRE, "agent");
            xb_add(&bar[XB_XGEN2(x)], 1u);
            asm volatile("s_waitcnt vmcnt(0)" ::: "memory");
        } else {
            XB_SPIN(xb_ld(&bar[XB_XGEN2(x)]) == gen, bar);
            __builtin_amdgcn_fence(__ATOMIC_ACQUIRE, "agent");
            asm volatile("s_waitcnt vmcnt(0)" ::: "memory");
        }
    }
    __syncthreads();
}

struct Args { const float* in[21]; float* out; unsigned char* ws; };
#define GRID_SYNC() do { XcdBarrier bar_; bar_.bar = (unsigned*)(ws + WS_CTL); bar_.x = xb_xcc_id(); bar_.st = (volatile LAS unsigned*)((LAS unsigned char*)lds + MISC_OFF) + 8; xcd_barrier(bar_, fresh_tid(my_wave) == 0); } while (0)
#define LOCAL_SYNC_EX(arrive_, wait_) LOCAL_SYNC_EX2(arrive_, wait_, XB_TOP3)
#define LOCAL_SYNC_EX2(arrive_, wait_, topw_) do { unsigned z_ = 0u; asm volatile("" : "+v"(z_)); LAS unsigned* fa_ = (LAS unsigned*)((LAS unsigned char*)lds + MISC_OFF + z_) + 12; \
        if (__builtin_amdgcn_readfirstlane(*(volatile LAS unsigned*)fa_) != 0u) xcc_barrier((unsigned*)(ws + WS_CTL), xb_xcc_id(), fresh_tid(my_wave) == 0, (arrive_), (wait_), (topw_)); else GRID_SYNC(); } while (0)
#define LOCAL_SYNC() LOCAL_SYNC_EX(false, 0u)

__global__ void __launch_bounds__(NTHR, 2) fwd_megakernel(Args args) {
    extern __shared__ __attribute__((aligned(16))) unsigned char lds[];
    cg::grid_group grid = cg::this_grid();
    const int my_wave = __builtin_amdgcn_readfirstlane(threadIdx.x >> 6);
    Ctx C;
    typedef const __attribute__((address_space(4))) unsigned long long* kargp_t;
    kargp_t kp;
#define FRESH_CTX() do { const int t_ = fresh_tid(my_wave); C.lds = lds; C.tid = t_; C.lane = t_ & 63; C.wave = __builtin_amdgcn_readfirstlane(t_ >> 6); \
        C.gw = blockIdx.x * NWAVES + C.wave; C.ngw = gridDim.x * NWAVES; kp = (kargp_t)__builtin_amdgcn_kernarg_segment_ptr(); asm volatile("" : "+s"(kp)); G = gridDim.x; { unsigned z_ = 0u; asm volatile("" : "+v"(z_)); LAS unsigned* ra_ = (LAS unsigned*)((LAS unsigned char*)lds + MISC_OFF + z_) + 10; bid = (int)__builtin_amdgcn_readfirstlane(*(volatile LAS unsigned*)ra_); } asm volatile("" : "+s"(G), "+s"(bid)); } while (0)
#define GASP __attribute__((address_space(1)))
#define IN(k) ((const float*)(const GASP float*)kp[k])
#define xout ((float*)(GASP float*)kp[21])
#define ws ((unsigned char*)(GASP unsigned char*)kp[22])
#define x_in IN(0)
#define ZA ((bf16_t*)(ws + WS_ZA))
#define QKV ((bf16_t*)(ws + WS_QKV))
#define ZC ((bf16_t*)(ws + WS_ZC))
#define GB ((bf16_t*)(ws + WS_G))
#define G8B ((unsigned char*)(ws + WS_G))
#define H8B ((G == 256) ? (unsigned char*)xout + 32 * MiB : (unsigned char*)(ws + WS_MG))
#define MGB ((bf16_t*)(ws + WS_MG))
#define HB ((bf16_t*)(ws + WS_H))
#define PB ((float*)(ws + WS_P))
    int G, bid;
    FRESH_CTX();
    for (int u = C.tid; u < (LDS_BYTES - LDSCTL_OFF) / 4; u += NTHR) ((LAS unsigned*)((LAS unsigned char*)lds + LDSCTL_OFF))[u] = 0u;
    __syncthreads();
    (void)xcd_barrier_post((unsigned*)(ws + WS_CTL), (volatile LAS unsigned*)((LAS unsigned char*)lds + MISC_OFF) + 8);
    __syncthreads();
    FRESH_CTX();
    if (G == 0x7fffffff) grid.sync();

    convert_mixer_weights(C, IN(2), IN(14), IN(15), IN(12), ws);
    for (int m = C.gw; m < MTOK; m += 4 * C.ngw) rms_rows4_to_bf16(x_in, IN(1), HB, H8B, m, C.ngw, C.lane);
    { u32x4* z = (u32x4*)(ws + WS_XH); const int nz = (int)((2 * MiB) / 16);
      for (int i = (bid * NTHR + C.tid); i < nz; i += G * NTHR) z[i] = (u32x4){0u, 0u, 0u, 0u};
      u32x4* z2 = (u32x4*)(ws + WS_XS); const int nz2 = (int)((8 * XS_BANK) / 16);
      for (int i = (bid * NTHR + C.tid); i < nz2; i += G * NTHR) z2[i] = (u32x4){0u, 0u, 0u, 0u}; }
    GRID_SYNC();
    if (fresh_tid(my_wave) == 0) {
        volatile LAS unsigned* misc = (volatile LAS unsigned*)((LAS unsigned char*)lds + MISC_OFF);
        unsigned* barw = (unsigned*)(ws + WS_CTL); bool ok = (gridDim.x == 256);
#pragma unroll
        for (int j = 0; j < 8; ++j) ok = ok && (xb_ld(&barw[XB_XCNT(j)]) == 32u);
        const unsigned xme = xb_xcc_id();
        if (ok && xme < 8u) { misc[10] = misc[11] * 8u + xme; misc[12] = 1u; }
    }
    __syncthreads();

#pragma unroll 1
    for (int l = 0; l < 2; ++l) {

        FRESH_CTX();
        { Gemm g{1024, 1024}; StaticOrder S; S.init(MTOK, 3072, G, bid, HB, 1024, (const bf16_t*)(ws + WS_WIN), 1024);
          EpiIn E{ZA, QKV, ZC};
          GEMM_PHASE(EpiIn, StaticOrder, g, S, E); }
        FRESH_CTX();
        { Gemm g{512, 512}; StaticOrder S; S.init(MTOK, 3072, G, bid, (const bf16_t*)H8B, 512, (const bf16_t*)(ws + WS_WG8), 512);
          EpiGate E{G8B};
          GEMM_PHASE(EpiGate, StaticOrder, g, S, E); }
        GRID_SYNC();
        FRESH_CTX();
        { const float linit = 0.8f - 0.6f * expf(-0.3f * (float)l);
          const float d1 = wave_sum(IN(7)[l * 64 + C.lane] * IN(8)[l * 64 + C.lane]), d2 = wave_sum(IN(9)[l * 64 + C.lane] * IN(10)[l * 64 + C.lane]);
          const float lam = expf(d1) - expf(d2) + linit;
          const int vcu = (G % 8 == 0) ? (bid % 8) * (G / 8) + bid / 8 : bid;
#define MIX_LIGHT(u_) do { const int uu_ = (u_); if (uu_ & 1) pool_unit(C, uu_ >> 1, ZC, (const bf16_t*)(ws + WS_WPOOL), IN(13) + l * 512, HB); \
              else gmlp_unit(C, uu_ >> 1, ZA, IN(3) + l * 512, IN(4) + l * 512, IN(5) + (size_t)l * 4 * 128 * 128, IN(6) + l * 512); } while (0)
          int njobs, jgrp, jq0, jq1, jvlo, jvhi, jstep, side_pos = -1;
          if (G == 256) {
              const int sx = vcu & 7, kx = sx & 3;
              side_pos = (vcu >> 3) % 3;
              njobs = 2; jgrp = vcu >> 3; jq0 = 7 - kx; jq1 = kx; jvlo = jvhi = sx >> 2; jstep = 0;
          } else {
#pragma unroll 1
              for (int u = bid; u < 1024; u += G) MIX_LIGHT(u);
              njobs = (256 - bid + G - 1) / G; jgrp = 0; jq0 = 0; jq1 = 0; jvlo = 0; jvhi = 1; jstep = G;
          }
#define MIX_SIDE() do { __syncthreads(); FRESH_CTX(); \
              convert_ffn_weights(C, IN(18) + (size_t)l * 1024 * 2 * DFF, IN(19) + (size_t)l * DFF * 1024, ws); __syncthreads(); \
              _Pragma("unroll 1") for (int jl_ = 0; jl_ < 4; ++jl_) MIX_LIGHT(((G % 8 == 0) ? (bid % 8) * (G / 8) + bid / 8 : bid) * 4 + jl_); } while (0)
#pragma unroll 1
          for (int j = 0; j <= njobs; ++j) {
              if (j == side_pos) MIX_SIDE();
              if (j == njobs) break;
              int grp_, qb_;
              if (jstep == 0) { grp_ = jgrp; qb_ = (j == 0) ? jq0 : jq1; } else { const int a = bid + j * jstep; grp_ = a >> 3; qb_ = a & 7; }
              const int b_ = grp_ >> 2, h_ = grp_ & 3;
#pragma unroll 1
              for (int p_ = 2 * jvlo; p_ < 2 * jvhi + 2; ++p_) { const int c_ = p_ & 1, vh_ = p_ >> 1;
                  attn_body::attn_unit<8>(b_, qb_, QKV + h_ * 128 + c_ * 64, QKV + 512 + h_ * 128 + c_ * 64, QKV + 1024 + h_ * 128 + vh_ * 64, c_, vh_, lam, (char*)lds, my_wave); }
              if (jvlo == jvhi) attn_body::attn_finish_half(b_, h_, qb_, jvlo, HB, IN(11) + l * 128, 1.0f - linit, (unsigned long long*)(ws + WS_XH) + ((size_t)(l * 32 + grp_) * 8 + qb_) * 512, (char*)lds, my_wave);
              else attn_body::attn_finish(b_, h_, qb_, HB, IN(11) + l * 128, 1.0f - linit, (char*)lds, my_wave);
          }
#undef MIX_SIDE
#undef MIX_LIGHT
        }
        LOCAL_SYNC_EX(true, 0u);
        FRESH_CTX();
        if (G != 256) convert_ffn_weights(C, IN(18) + (size_t)l * 1024 * 2 * DFF, IN(19) + (size_t)l * DFF * 1024, ws);
        __syncthreads();
        FRESH_CTX();
        { Gemm g{1024, 512}; BranchOrder S; S.so.init(MTOK, 1024, G, bid, nullptr, 1024, nullptr, 512);
          S.A0 = ZA; S.Bt = (const bf16_t*)(ws + WS_WB); S.bstride = (size_t)1024 * 512;
          EpiBranch E{G8B, MGB};
          GEMM_PHASE(EpiBranch, BranchOrder, g, S, E); }
        LOCAL_SYNC();
        if (G == 256) {
            FRESH_CTX();
            { Gemm g{1024, 1024}; StaticOrder S; S.init(MTOK, 1024, G, bid, MGB, 1024, (const bf16_t*)(ws + WS_WOUT), 1024);
              const PanelRms p1{(unsigned long long*)(ws + WS_XS + (size_t)(4 * l + 0) * XS_BANK)}, p2{(unsigned long long*)(ws + WS_XS + (size_t)(4 * l + 1) * XS_BANK)};
              if (l == 0) { EpiRmsRes<false> E{x_in, nullptr, ZA, IN(16) + l * DM, IN(17) + l * DM, HB, nullptr, p1, p2}; GEMM_PHASE(EpiRmsRes<false>, StaticOrder, g, S, E); }
              else { EpiRmsRes<true> E{(const bf16_t*)xout, nullptr, ZA, IN(16) + l * DM, IN(17) + l * DM, HB, nullptr, p1, p2}; GEMM_PHASE(EpiRmsRes<true>, StaticOrder, g, S, E); } }
            LOCAL_SYNC_EX(false, 8u * (unsigned)(l + 1));
        } else {
            FRESH_CTX();
            { Gemm g{1024, 1024}; StaticOrder S; S.init(MTOK, 1024, G, bid, MGB, 1024, (const bf16_t*)(ws + WS_WOUT), 1024);
              EpiF32 E{PB};
              GEMM_PHASE(EpiF32, StaticOrder, g, S, E); }
            GRID_SYNC();
            FRESH_CTX();
            for (int m = C.gw; m < MTOK; m += C.ngw)
                res_norm_row(PB + (size_t)m * DM, ((l == 0) ? x_in : (const float*)xout) + (size_t)m * DM, xout + (size_t)m * DM, IN(16) + l * DM, IN(17) + l * DM, HB + (size_t)m * DM, nullptr, C.lane);
            GRID_SYNC();
        }
        FRESH_CTX();
        { Gemm g{1024, 1024}; StaticOrder S; S.init(MTOK, 2 * DFF, G, bid, HB, 1024, (const bf16_t*)(ws + WS_WF1), 1024);
          EpiSwiglu E{GB};
          GEMM_PHASE(EpiSwiglu, StaticOrder, g, S, E); }
        if (l == 0) LOCAL_SYNC_EX2(true, 0u, XB_TOP4); else GRID_SYNC();
        FRESH_CTX();
        bool lm7; { unsigned z_ = 0u; asm volatile("" : "+v"(z_)); LAS unsigned* fa_ = (LAS unsigned*)((LAS unsigned char*)lds + MISC_OFF + z_) + 12; lm7 = __builtin_amdgcn_readfirstlane(*(volatile LAS unsigned*)fa_) != 0u; }
        if (l == 0 && !lm7) convert_mixer_weights(C, IN(2) + (size_t)1024 * IN_TOTAL, IN(14) + (size_t)3 * 512 * 1024, IN(15) + (size_t)1024 * 1024, IN(12) + (size_t)4 * 128 * 128, ws);
        __syncthreads();
        if (G == 256) {
            FRESH_CTX();
            { Gemm g{DFF, DFF}; StaticOrder S; S.init(MTOK, 1024, G, bid, GB, DFF, (const bf16_t*)(ws + WS_WF2), DFF);
              const PanelRms p1{(unsigned long long*)(ws + WS_XS + (size_t)(4 * l + 2) * XS_BANK)}, p2{(unsigned long long*)(ws + WS_XS + (size_t)(4 * l + 3) * XS_BANK)};
              EpiRmsRes<true> E{ZA, (l == 0) ? nullptr : xout, (bf16_t*)xout, IN(20) + l * DM, (l == 0) ? IN(1) + DM : nullptr, HB, H8B, p1, p2};
              GEMM_PHASE(EpiRmsRes<true>, StaticOrder, g, S, E); }
        } else {
            FRESH_CTX();
            { Gemm g{DFF, DFF}; StaticOrder S; S.init(MTOK, 1024, G, bid, GB, DFF, (const bf16_t*)(ws + WS_WF2), DFF);
              EpiF32 E{PB};
              GEMM_PHASE(EpiF32, StaticOrder, g, S, E); }
            GRID_SYNC();
            FRESH_CTX();
            for (int m = C.gw; m < MTOK; m += C.ngw)
                res_norm_row(PB + (size_t)m * DM, xout + (size_t)m * DM, xout + (size_t)m * DM, IN(20) + l * DM, (l == 0) ? IN(1) + DM : nullptr, HB + (size_t)m * DM, H8B + (size_t)m * DM, C.lane);
        }
        if (l == 0) {
            FRESH_CTX();
            bool lm8; { unsigned z_ = 0u; asm volatile("" : "+v"(z_)); LAS unsigned* fa_ = (LAS unsigned*)((LAS unsigned char*)lds + MISC_OFF + z_) + 12; lm8 = __builtin_amdgcn_readfirstlane(*(volatile LAS unsigned*)fa_) != 0u; }
            if (lm8) {
                if (C.tid == 0) { unsigned* barw = (unsigned*)(ws + WS_CTL); XB_SPIN(xb_ld(&barw[XB_TOP4]) < 8u, barw); }
                __syncthreads();
                convert_mixer_weights(C, IN(2) + (size_t)1024 * IN_TOTAL, IN(14) + (size_t)3 * 512 * 1024, IN(15) + (size_t)1024 * 1024, IN(12) + (size_t)4 * 128 * 128, ws);
            }
            GRID_SYNC();
        }
    }
}

#undef IN
#undef xout
#undef ws
#undef x_in
#undef ZA
#undef QKV
#undef ZC
#undef GB
#undef G8B
#undef H8B
#undef MGB
#undef HB
#undef PB
extern "C" void kernel_launch(void* const* d_in, const int* in_sizes, int n_in, void* d_out, int out_size, void* d_ws, size_t ws_size, hipStream_t stream) {
    static int grid = 0;
    if (grid == 0) {
        if (n_in != 21 || out_size != MTOK * DM || ws_size < WS_END) { fprintf(stderr, "kernel_launch: unexpected problem (n_in %d out %d ws %zu)\n", n_in, out_size, ws_size); grid = -1; return; }
        int dev = 0, cus = 0, per_cu = 0;
        hipGetDevice(&dev); hipDeviceGetAttribute(&cus, hipDeviceAttributeMultiprocessorCount, dev);
        hipFuncSetAttribute((const void*)fwd_megakernel, hipFuncAttributeMaxDynamicSharedMemorySize, LDS_BYTES);
        hipOccupancyMaxActiveBlocksPerMultiprocessor(&per_cu, (const void*)fwd_megakernel, NTHR, LDS_BYTES);
        if (per_cu < 1) { fprintf(stderr, "kernel_launch: occupancy query says %d\n", per_cu); per_cu = 1; }
        (void)hipGetLastError();
        grid = cus * 1;
    }
    if (grid < 0) return;
    if (hipMemsetAsync((char*)d_ws + WS_CTL, 0, CTL_ZERO_BYTES, stream) != hipSuccess) { fprintf(stderr, "kernel_launch: memset of the barrier words failed\n"); return; }
    Args a{};
    for (int i = 0; i < 21; ++i) a.in[i] = (const float*)d_in[i];
    a.out = (float*)d_out; a.ws = (unsigned char*)d_ws;
    void* kargs[] = {&a};
    hipError_t e = hipLaunchCooperativeKernel((const void*)fwd_megakernel, dim3(grid), dim3(NTHR), kargs, LDS_BYTES, stream);
    if (e != hipSuccess) fprintf(stderr, "cooperative launch failed: %s (grid %d)\n", hipGetErrorString(e), grid);
}
```

```cpp
#include <hip/hip_runtime.h>
#include <hip/hip_cooperative_groups.h>
#include <cstdio>
#include <cstdint>
#include <cmath>
namespace cg = cooperative_groups;

typedef unsigned short bf16_t;
typedef short bf16x8 __attribute__((ext_vector_type(8)));
typedef float f32x4 __attribute__((ext_vector_type(4)));
typedef float f32x2 __attribute__((ext_vector_type(2)));
typedef unsigned u32x4 __attribute__((ext_vector_type(4)));
typedef unsigned u32x2 __attribute__((ext_vector_type(2)));
typedef int v4i_t __attribute__((ext_vector_type(4)));
typedef int v8i_t __attribute__((ext_vector_type(8)));

constexpr int NB = 8, SEQ = 2048, DM = 1024, MTOK = NB * SEQ;
constexpr int IN_TOTAL = 6144, DFF = 2816;
constexpr int NWAVES = 8, NTHR = 512;
constexpr float EPS = 1e-6f;
constexpr float C2 = 0.125f * 1.4426950408889634f;
constexpr int LDS_BYTES = 147456;

constexpr size_t MiB = 1u << 20;
constexpr size_t WS_W = 0;
constexpr size_t WS_WIN = 0, WS_WG8 = 6 * MiB, WS_WB = 12 * MiB, WS_WOUT = 15 * MiB, WS_WPOOL = 17 * MiB;
constexpr float WG8_SCALE = 32.0f;
constexpr size_t WS_WF1 = 0, WS_WF2 = 246 * MiB + 512 * 1024;
constexpr size_t WS_ZA = 18 * MiB;
constexpr size_t WS_QKV = 50 * MiB;
constexpr size_t WS_ZC = 98 * MiB;
constexpr size_t WS_P = 50 * MiB;
constexpr size_t WS_MG = 162 * MiB;
constexpr size_t WS_G = 114 * MiB;
constexpr size_t WS_H = 210 * MiB;
constexpr size_t WS_XH = 242 * MiB + 512 * 1024;
constexpr size_t WS_XS = 252 * MiB, XS_BANK = 512 * 1024;
constexpr size_t WS_END = 256 * MiB;
constexpr int CW_SEAM = 4096, SEAM_BANK = 64 * 64;

__device__ __forceinline__ unsigned f2bf(float f) { unsigned u = __builtin_bit_cast(unsigned, f); return (u + 0x7fffu + ((u >> 16) & 1u)) >> 16; }
__device__ __forceinline__ unsigned pk2(float lo, float hi) { unsigned r; asm("v_cvt_pk_bf16_f32 %0, %1, %2" : "=v"(r) : "v"(lo), "v"(hi)); return r; }
__device__ __forceinline__ unsigned pk4_fp8(float a, float b, float c, float d) { int w = 0; w = __builtin_amdgcn_cvt_pk_fp8_f32(a, b, w, false); w = __builtin_amdgcn_cvt_pk_fp8_f32(c, d, w, true); return (unsigned)w; }
__device__ __forceinline__ float bflo(unsigned w) { return __uint_as_float(w << 16); }
__device__ __forceinline__ float bfhi(unsigned w) { return __uint_as_float(w & 0xffff0000u); }
__device__ __forceinline__ float bf1(bf16_t b) { return __uint_as_float(((unsigned)b) << 16); }
__device__ __forceinline__ int fresh_tid(int wave) { int t = wave * 64 + (int)__builtin_amdgcn_mbcnt_hi(~0u, __builtin_amdgcn_mbcnt_lo(~0u, 0u)); asm volatile("" : "+v"(t)); return t; }
__device__ __forceinline__ float wave_sum(float v) {
#pragma unroll
    for (int o = 1; o < 64; o <<= 1) v += __shfl_xor(v, o);
    return v;
}
__device__ __forceinline__ float wave_max(float v) {
#pragma unroll
    for (int o = 1; o < 64; o <<= 1) v = fmaxf(v, __shfl_xor(v, o));
    return v;
}

__device__ __forceinline__ float gelu1(float v) {
    const float av = fabsf(v), t = __builtin_amdgcn_rcpf(av * 0.2316418882f + 1.0f);
    float q = t * 0.5307027145f + (-0.7265760135f); q = q * t + 0.7107068705f; q = q * t + (-0.142248368f); q = q * t + 0.127414796f; q = q * t;
    const float e = __builtin_amdgcn_exp2f((v * v) * (-0.72134752044f));
    const float m = v * (q * e);
    return v < 0.f ? m : v - m;
}
__device__ __forceinline__ float sigmoid1(float v) { return __builtin_amdgcn_rcpf(1.0f + __builtin_amdgcn_exp2f(v * -1.4426950408889634f)); }

struct Unit { int pm, pn, n; const bf16_t* A; const bf16_t* B; };
struct Gemm { int lda; int K; };
__host__ __device__ __forceinline__ int perm32(int rho) { const int n = rho >> 4, i = rho & 15; return 8 * (i >> 2) + 4 * n + (i & 3); }

constexpr int NXCD = 8, WGM = 4;
struct StaticOrder {
    int nM, nN, nwg, G, c; const bf16_t* A; const bf16_t* Bt; size_t atile, btile;
    __device__ void init(int M, int N, int G_, int c_, const bf16_t* A_, int lda, const bf16_t* Bt_, int K) { nM = M / 256; nN = N / 256; nwg = nM * nN; G = G_; c = c_; A = A_; Bt = Bt_; atile = (size_t)256 * lda; btile = (size_t)256 * K; }
    __device__ bool tile(int i, int& pm, int& pn) const {
        const long L = (long)i * G + c; if (L >= nwg) return false;
        int wgid = (int)L; { const int q = nwg / NXCD, r = nwg % NXCD, xcd = wgid % NXCD, off = wgid / NXCD; wgid = (xcd < r ? xcd * (q + 1) : r * (q + 1) + (xcd - r) * q) + off; }
        const int nig = WGM * nN, gid = wgid / nig, fm = gid * WGM, gsz = (nM - fm) < WGM ? (nM - fm) : WGM;
        pm = fm + ((wgid % nig) % gsz); pn = (wgid % nig) / gsz; return true;
    }
    __device__ bool next(int i, Unit& u) const { if (!tile(i, u.pm, u.pn)) return false; u.n = 0; u.A = A + u.pm * atile; u.B = Bt + u.pn * btile; return true; }
};
struct BranchOrder {
    StaticOrder so; const bf16_t* A0; const bf16_t* Bt; size_t bstride;
    __device__ bool next(int i, Unit& u) const {
        const int ti = i / 3, n = i - 3 * ti;
        if (!so.tile(ti, u.pm, u.pn)) return false;
        u.n = n; const size_t aoff = (size_t)(n > 0 ? 1 : 0) * ((WS_H - WS_ZA) / 2) + (size_t)(n > 1 ? 1 : 0) * 512;
        u.A = A0 + aoff + u.pm * so.atile; u.B = Bt + (size_t)n * bstride + u.pn * so.btile; return true;
    }
};

struct EpiIn {
    static constexpr bool PERM = true, AFTER_DRAIN = false, CHAIN = false, FP8 = false;
    bf16_t *ZA, *QKV, *ZC;
    __device__ __forceinline__ void operator()(const f32x4 (&acc)[2][2][4][2], const Unit& u, int wr, int wc, int fr, int fq) const {
        const int pn = u.pn; const int row0 = u.pm * 256 + wr * 64 + fr;
        bf16_t* base; int ldc, colt; bool act = false; float sc = 1.f;
        if (pn < 4) { base = ZA; ldc = 1024; colt = pn * 256; act = true; }
        else if (pn < 10) { base = QKV; ldc = 1536; colt = (pn - 4) * 256; if (pn < 6) sc = C2; }
        else { base = ZC; ldc = 512; colt = (pn - 10) * 256; }
        const int col0 = colt + wc * 32 + 8 * fq;
#pragma unroll
        for (int ai = 0; ai < 2; ++ai)
#pragma unroll
            for (int m = 0; m < 4; ++m) { bf16_t* rowp = base + (size_t)(row0 + ai * 128 + m * 16) * ldc + col0;
#pragma unroll
                for (int bj = 0; bj < 2; ++bj) { f32x4 v0 = acc[ai][bj][m][0], v1 = acc[ai][bj][m][1];
                    if (act) {
#pragma unroll
                        for (int e = 0; e < 4; ++e) { v0[e] = gelu1(v0[e]); v1[e] = gelu1(v1[e]); }
                    }
                    v0 = v0 * sc; v1 = v1 * sc;
                    u32x4 w; w.x = pk2(v0[0], v0[1]); w.y = pk2(v0[2], v0[3]); w.z = pk2(v1[0], v1[1]); w.w = pk2(v1[2], v1[3]);
                    *(u32x4*)(rowp + bj * 128) = w; } }
    }
};
struct EpiGate {
    static constexpr bool PERM = true, AFTER_DRAIN = false, CHAIN = false, FP8 = true;
    unsigned char* G8;
    __device__ __forceinline__ void operator()(const f32x4 (&acc)[2][2][4][2], const Unit& u, int wr, int wc, int fr, int fq) const {
        const int row0 = u.pm * 256 + wr * 64 + fr, col0 = u.pn * 256 + wc * 32 + 8 * fq;
#pragma unroll
        for (int ai = 0; ai < 2; ++ai)
#pragma unroll
            for (int m = 0; m < 4; ++m) { unsigned char* rowp = G8 + (size_t)(row0 + ai * 128 + m * 16) * 3072 + col0;
#pragma unroll
                for (int bj = 0; bj < 2; ++bj) { unsigned q[8];
#pragma unroll
                    for (int e = 0; e < 4; ++e) { q[e] = (unsigned)fminf(sigmoid1(acc[ai][bj][m][0][e] * (1.0f / WG8_SCALE)) * 256.0f, 255.0f); q[4 + e] = (unsigned)fminf(sigmoid1(acc[ai][bj][m][1][e] * (1.0f / WG8_SCALE)) * 256.0f, 255.0f); }
                    u32x2 w; w.x = q[0] | (q[1] << 8) | (q[2] << 16) | (q[3] << 24); w.y = q[4] | (q[5] << 8) | (q[6] << 16) | (q[7] << 24);
                    *(u32x2*)(rowp + bj * 128) = w; } }
    }
};
__device__ __forceinline__ void gate8(const u32x2 w, f32x4& g0, f32x4& g1) {
    g0 = (f32x4){(float)(w.x & 0xffu), (float)((w.x >> 8) & 0xffu), (float)((w.x >> 16) & 0xffu), (float)(w.x >> 24)};
    g1 = (f32x4){(float)(w.y & 0xffu), (float)((w.y >> 8) & 0xffu), (float)((w.y >> 16) & 0xffu), (float)(w.y >> 24)};
    g0 = g0 * (1.0f / 256.0f) + (0.5f / 256.0f); g1 = g1 * (1.0f / 256.0f) + (0.5f / 256.0f);
}
struct EpiBranch {
    static constexpr bool PERM = true, AFTER_DRAIN = false, CHAIN = true, FP8 = false;
    const unsigned char* G8; bf16_t* MG;
    __device__ __forceinline__ void operator()(f32x4 (&acc)[2][2][4][2], const Unit& u, int wr, int wc, int fr, int fq) const {
        const int n = u.n; const int row0 = u.pm * 256 + wr * 64 + fr, col0 = u.pn * 256 + wc * 32 + 8 * fq;
#pragma unroll
        for (int ai = 0; ai < 2; ++ai) {
            u32x2 gw[4][2], hw[4][2];
#pragma unroll
            for (int m = 0; m < 4; ++m)
#pragma unroll
                for (int bj = 0; bj < 2; ++bj) { const unsigned char* gp = G8 + (size_t)(row0 + ai * 128 + m * 16) * 3072 + n * 1024 + col0 + bj * 128;
                    gw[m][bj] = *(const u32x2*)gp; hw[m][bj] = (n < 2) ? *(const u32x2*)(gp + 1024) : (u32x2){0u, 0u}; }
#pragma unroll
            for (int m = 0; m < 4; ++m) { const size_t row = (size_t)(row0 + ai * 128 + m * 16);
#pragma unroll
                for (int bj = 0; bj < 2; ++bj) { const int col = col0 + bj * 128;
                    f32x4 g0, g1; gate8(gw[m][bj], g0, g1);
                    if (n < 2) { f32x4 h0, h1; gate8(hw[m][bj], h0, h1);
#pragma unroll
                        for (int e = 0; e < 4; ++e) { g0[e] *= __builtin_amdgcn_rcpf(h0[e]); g1[e] *= __builtin_amdgcn_rcpf(h1[e]); }
                        acc[ai][bj][m][0] *= g0; acc[ai][bj][m][1] *= g1;
                    } else { const f32x4 v0 = acc[ai][bj][m][0] * g0, v1 = acc[ai][bj][m][1] * g1;
                        u32x4 w; w.x = pk2(v0[0], v0[1]); w.y = pk2(v0[2], v0[3]); w.z = pk2(v1[0], v1[1]); w.w = pk2(v1[2], v1[3]); *(u32x4*)(MG + row * 1024 + col) = w; } } }
            asm volatile("" ::: "memory");
        }
    }
};
struct EpiF32 {
    static constexpr bool PERM = true, AFTER_DRAIN = false, CHAIN = false, FP8 = false;
    float* O;
    __device__ __forceinline__ void operator()(const f32x4 (&acc)[2][2][4][2], const Unit& u, int wr, int wc, int fr, int fq) const {
        const int row0 = u.pm * 256 + wr * 64 + fr, col0 = u.pn * 256 + wc * 32 + 8 * fq;
#pragma unroll
        for (int ai = 0; ai < 2; ++ai)
#pragma unroll
            for (int m = 0; m < 4; ++m) { float* rowp = O + (size_t)(row0 + ai * 128 + m * 16) * 1024 + col0;
#pragma unroll
                for (int bj = 0; bj < 2; ++bj) { *(f32x4*)(rowp + bj * 128) = acc[ai][bj][m][0]; *(f32x4*)(rowp + bj * 128 + 4) = acc[ai][bj][m][1]; } }
    }
};
struct EpiSwiglu {
    static constexpr bool PERM = true, AFTER_DRAIN = false, CHAIN = false, FP8 = false;
    bf16_t* F;
    __device__ __forceinline__ void operator()(const f32x4 (&acc)[2][2][4][2], const Unit& u, int wr, int wc, int fr, int fq) const {
        const int row0 = u.pm * 256 + wr * 64 + fr, col0 = u.pn * 128 + wc * 32 + 8 * fq;
#pragma unroll
        for (int ai = 0; ai < 2; ++ai)
#pragma unroll
            for (int m = 0; m < 4; ++m) { bf16_t* rowp = F + (size_t)(row0 + ai * 128 + m * 16) * DFF + col0;
                f32x4 v0, v1;
#pragma unroll
                for (int e = 0; e < 4; ++e) { const float g0 = acc[ai][0][m][0][e], g1 = acc[ai][0][m][1][e];
                    v0[e] = g0 * sigmoid1(g0) * acc[ai][1][m][0][e]; v1[e] = g1 * sigmoid1(g1) * acc[ai][1][m][1][e]; }
                u32x4 w; w.x = pk2(v0[0], v0[1]); w.y = pk2(v0[2], v0[3]); w.z = pk2(v1[0], v1[1]); w.w = pk2(v1[2], v1[3]);
                *(u32x4*)rowp = w; }
    }
};

#define EX_LAS __attribute__((address_space(3)))
struct PanelRms {
    unsigned long long* xbuf;
    __device__ __forceinline__ void run(const f32x4 (&v)[2][2][4][2], const Unit& u, int wr, int wc, int fr, int fq, EX_LAS unsigned char* lds, int wid, int lane) const {
        EX_LAS float* P = (EX_LAS float*)lds;
        EX_LAS float* S = (EX_LAS float*)(lds + 4096);
#pragma unroll
        for (int ai = 0; ai < 2; ++ai)
#pragma unroll
            for (int m = 0; m < 4; ++m) {
                float q = 0.f;
#pragma unroll
                for (int bj = 0; bj < 2; ++bj)
#pragma unroll
                    for (int n = 0; n < 2; ++n) { const f32x4 x = v[ai][bj][m][n]; q += (x[0] * x[0] + x[1] * x[1]) + (x[2] * x[2] + x[3] * x[3]); }
                q += __shfl_xor(q, 16); q += __shfl_xor(q, 32);
                if (fq == 0) P[(ai * 128 + wr * 64 + m * 16 + fr) * 4 + wc] = q;
            }
        asm volatile("s_waitcnt lgkmcnt(0)" ::: "memory"); __builtin_amdgcn_s_barrier(); asm volatile("" ::: "memory");
        const int row = wid * 32 + (lane & 31);
        if (lane < 32) {
            const float tot = (P[row * 4 + 0] + P[row * 4 + 1]) + (P[row * 4 + 2] + P[row * 4 + 3]);
            unsigned long long* slot = xbuf + (size_t)(u.pm * 256 + row) * 4;
            __hip_atomic_store(slot + u.pn, (1ull << 32) | (unsigned long long)__float_as_uint(tot), __ATOMIC_RELAXED, __HIP_MEMORY_SCOPE_AGENT);
            float ss = 0.f;
#pragma unroll
            for (int t = 0; t < 4; ++t) { unsigned long long w = 0ull;
#pragma unroll 1
                for (unsigned it = 0; it < (1u << 20); ++it) { w = __hip_atomic_load(slot + t, __ATOMIC_RELAXED, __HIP_MEMORY_SCOPE_AGENT); if ((w >> 32) != 0ull) break; __builtin_amdgcn_s_sleep(1); }
                ss += __uint_as_float((unsigned)w); }
            S[row] = 1.0f / sqrtf(ss * (1.0f / 1024.0f) + EPS);
        }
        asm volatile("s_waitcnt vmcnt(0) lgkmcnt(0)" ::: "memory"); __builtin_amdgcn_s_barrier(); asm volatile("" ::: "memory");
    }
};
template <bool BASE_BF>
struct EpiRmsRes {
    static constexpr bool PERM = true, AFTER_DRAIN = true, CHAIN = false, FP8 = false;
    const void* base; float* out_f32; bf16_t* out_bf; const float* gpost; const float* gnext; bf16_t* xn; unsigned char* xn8; PanelRms st1, st2;
    __device__ __forceinline__ void operator()(const f32x4 (&)[2][2][4][2], const Unit&, int, int, int, int) const {}
    __device__ __forceinline__ void fused(f32x4 (&acc)[2][2][4][2], const Unit& u, int wr, int wc, int fr, int fq, EX_LAS unsigned char* lds, int wid, int lane) const {
        const EX_LAS float* S = (const EX_LAS float*)(lds + 4096);
        const int col0 = u.pn * 256 + wc * 32 + 8 * fq;
        u32x4 preb[2][4][2]; f32x4 pref[4][2][2];
        if constexpr (BASE_BF) {
#pragma unroll
            for (int ai = 0; ai < 2; ++ai)
#pragma unroll
                for (int m = 0; m < 4; ++m) { const size_t off = (size_t)(u.pm * 256 + ai * 128 + wr * 64 + m * 16 + fr) * 1024 + col0;
#pragma unroll
                    for (int bj = 0; bj < 2; ++bj) preb[ai][m][bj] = *(const u32x4*)((const bf16_t*)base + off + bj * 128); }
        } else {
#pragma unroll
            for (int m = 0; m < 4; ++m) { const size_t off = (size_t)(u.pm * 256 + wr * 64 + m * 16 + fr) * 1024 + col0;
#pragma unroll
                for (int bj = 0; bj < 2; ++bj)
#pragma unroll
                    for (int n = 0; n < 2; ++n) pref[m][bj][n] = *(const f32x4*)((const float*)base + off + bj * 128 + n * 4); }
        }
        f32x4 gp_[2][2];
#pragma unroll
        for (int bj = 0; bj < 2; ++bj) { gp_[bj][0] = *(const f32x4*)(gpost + col0 + bj * 128); gp_[bj][1] = *(const f32x4*)(gpost + col0 + bj * 128 + 4); }
        st1.run(acc, u, wr, wc, fr, fq, lds, wid, lane);
#pragma unroll
        for (int ai = 0; ai < 2; ++ai)
#pragma unroll
            for (int m = 0; m < 4; ++m) { const int r = ai * 128 + wr * 64 + m * 16 + fr; const float sr = S[r]; const size_t off = (size_t)(u.pm * 256 + r) * 1024 + col0;
#pragma unroll
                for (int bj = 0; bj < 2; ++bj) {
                    f32x4 b0, b1;
                    if constexpr (BASE_BF) { const u32x4 w = preb[ai][m][bj]; b0 = (f32x4){bflo(w.x), bfhi(w.x), bflo(w.y), bfhi(w.y)}; b1 = (f32x4){bflo(w.z), bfhi(w.z), bflo(w.w), bfhi(w.w)}; }
                    else { b0 = (ai == 0) ? pref[m][bj][0] : *(const f32x4*)((const float*)base + off + bj * 128); b1 = (ai == 0) ? pref[m][bj][1] : *(const f32x4*)((const float*)base + off + bj * 128 + 4); }
                    acc[ai][bj][m][0] = b0 + acc[ai][bj][m][0] * sr * gp_[bj][0]; acc[ai][bj][m][1] = b1 + acc[ai][bj][m][1] * sr * gp_[bj][1]; }
                asm volatile("" : "+v"(acc[ai][0][m][0]), "+v"(acc[ai][0][m][1]), "+v"(acc[ai][1][m][0]), "+v"(acc[ai][1][m][1]));
                if (m & 1) asm volatile("" ::: "memory"); }
        f32x4 gn_[2][2];
#pragma unroll
        for (int bj = 0; bj < 2; ++bj) { gn_[bj][0] = gnext ? *(const f32x4*)(gnext + col0 + bj * 128) : (f32x4){0.f, 0.f, 0.f, 0.f}; gn_[bj][1] = gnext ? *(const f32x4*)(gnext + col0 + bj * 128 + 4) : (f32x4){0.f, 0.f, 0.f, 0.f}; }
        if (gnext) st2.run(acc, u, wr, wc, fr, fq, lds, wid, lane);
#pragma unroll
        for (int ai = 0; ai < 2; ++ai)
#pragma unroll
            for (int m = 0; m < 4; ++m) { const int r = ai * 128 + wr * 64 + m * 16 + fr; const float sr = S[r]; const size_t off = (size_t)(u.pm * 256 + r) * 1024 + col0;
#pragma unroll
                for (int bj = 0; bj < 2; ++bj) { const f32x4 x0 = acc[ai][bj][m][0], x1 = acc[ai][bj][m][1];
                    if (out_f32) { *(f32x4*)(out_f32 + off + bj * 128) = x0; *(f32x4*)(out_f32 + off + bj * 128 + 4) = x1; }
                    else { u32x4 w; w.x = pk2(x0[0], x0[1]); w.y = pk2(x0[2], x0[3]); w.z = pk2(x1[0], x1[1]); w.w = pk2(x1[2], x1[3]); *(u32x4*)(out_bf + off + bj * 128) = w; }
                    if (gnext) { const f32x4 h0 = x0 * sr * gn_[bj][0], h1 = x1 * sr * gn_[bj][1];
                        u32x4 w; w.x = pk2(h0[0], h0[1]); w.y = pk2(h0[2], h0[3]); w.z = pk2(h1[0], h1[1]); w.w = pk2(h1[2], h1[3]);
                        *(u32x4*)(xn + off + bj * 128) = w;
                        if (xn8) { u32x2 w8; w8.x = pk4_fp8(h0[0], h0[1], h0[2], h0[3]); w8.y = pk4_fp8(h1[0], h1[1], h1[2], h1[3]); *(u32x2*)(xn8 + off + bj * 128) = w8; } } }
                asm volatile("" ::: "memory"); }
    }
};

#define PG8_LAS __attribute__((address_space(3)))
constexpr int BK = 64, HALF = 128, HTB = HALF * BK * 2, STAGE_BYTES = 8 * HTB;
__host__ __device__ __forceinline__ int lds_byte(int r, int c) { const int st = (r >> 4) * 2 + (c >> 5), rr = r & 15, cc = c & 31, ob = rr * 64 + cc * 2; return st * 1024 + (ob ^ (((ob >> 9) & 1) << 5)); }
__host__ __device__ __forceinline__ void stage_rc(int b, int& R, int& C) { const int st = b / 1024, sb = b % 1024, swz = sb ^ (((sb >> 9) & 1) << 5); R = (st >> 1) * 16 + swz / 64; C = (st & 1) * 32 + (swz % 64) / 2; }

template <class Epi, class Sched>
__device__ __forceinline__ void gemm_phase(PG8_LAS unsigned char* lds, const Gemm g, const Sched& S, const Epi& E, int wave_) {
    const int tid_ = fresh_tid(wave_);
    const int tid = tid_, wid = __builtin_amdgcn_readfirstlane(tid >> 6), lane = tid & 63, wr = wid >> 2, wc = wid & 3, fr = lane & 15, fq = lane >> 4;
    const int K = g.K, nt = K / BK;
    unsigned voffA[2], voffB[2];
#pragma unroll
    for (int i = 0; i < 2; ++i) { int R, C; stage_rc(tid * 16 + i * 8192, R, C); const int Rb = Epi::PERM ? ((R & ~31) + perm32(R & 31)) : R;
        voffA[i] = (unsigned)(R * g.lda + C) * 2u; voffB[i] = (unsigned)(Rb * K + C) * 2u; }
    const size_t kstep = (size_t)(BK * 2);
    const size_t hstepA = (size_t)HALF * g.lda * 2, hstepB = (size_t)HALF * K * 2;
    const unsigned ldsw = (unsigned)wid * 1024u;
    const int aoff = lds_byte(wr * 64 + fr, fq * 8), boff = lds_byte(wc * 32 + fr, fq * 8);
#define PG8_SA(b, h) (((b) * 2 + (h)) * HTB)
#define PG8_SB(b, h) ((4 + (b) * 2 + (h)) * HTB)
#define PG8_STAGE(bufoff, gbase, voff) do { _Pragma("unroll") for (int _i = 0; _i < 2; ++_i) \
        __builtin_amdgcn_global_load_lds((const unsigned*)((const char*)(gbase) + (voff)[_i]), (PG8_LAS unsigned*)(lds + (bufoff) + ldsw + _i * 8192), 16, 0, 0); } while (0)
    PG8_LAS unsigned char* const fa = lds + aoff; PG8_LAS unsigned char* fb_ = lds + 4 * HTB + boff; asm volatile("" : "+v"(fb_)); PG8_LAS unsigned char* const fb = fb_;
#define PG8_FA(b, h) (((b) * 2 + (h)) * HTB)
#define PG8_FB(b, h) (((b) * 2 + (h)) * HTB)
#define PG8_LDA(dst, b, h) do { if constexpr (Epi::FP8) { _Pragma("unroll") for (int m = 0; m < 4; ++m) dst##8[m] = __builtin_shufflevector(*(const PG8_LAS v4i_t*)(fa + PG8_FA(b, h) + m * 2048), *(const PG8_LAS v4i_t*)(fa + PG8_FA(b, h) + m * 2048 + 1024), 0, 1, 2, 3, 4, 5, 6, 7); } \
        else { _Pragma("unroll") for (int m = 0; m < 4; ++m) _Pragma("unroll") for (int k = 0; k < 2; ++k) dst[m][k] = *(const PG8_LAS bf16x8*)(fa + PG8_FA(b, h) + m * 2048 + k * 1024); } } while (0)
#define PG8_LDB(dst, b, h) do { if constexpr (Epi::FP8) { _Pragma("unroll") for (int n = 0; n < 2; ++n) dst##8[n] = __builtin_shufflevector(*(const PG8_LAS v4i_t*)(fb + PG8_FB(b, h) + n * 2048), *(const PG8_LAS v4i_t*)(fb + PG8_FB(b, h) + n * 2048 + 1024), 0, 1, 2, 3, 4, 5, 6, 7); } \
        else { _Pragma("unroll") for (int n = 0; n < 2; ++n) _Pragma("unroll") for (int k = 0; k < 2; ++k) dst[n][k] = *(const PG8_LAS bf16x8*)(fb + PG8_FB(b, h) + n * 2048 + k * 1024); } } while (0)
#define PG8_MMA(ai, bj, At, Bt) do { __builtin_amdgcn_s_setprio(1); \
        if constexpr (Epi::FP8) { _Pragma("unroll") for (int m = 0; m < 4; ++m) _Pragma("unroll") for (int n = 0; n < 2; ++n) \
            asm volatile("v_mfma_f32_16x16x128_f8f6f4 %0, %1, %2, %0" : "+v"(acc[ai][bj][m][n]) : "v"(Bt##8[n]), "v"(At##8[m])); }   \
        else { _Pragma("unroll") for (int m = 0; m < 4; ++m) _Pragma("unroll") for (int n = 0; n < 2; ++n) _Pragma("unroll") for (int k = 0; k < 2; ++k) \
            acc[ai][bj][m][n] = __builtin_amdgcn_mfma_f32_16x16x32_bf16(Bt[n][k], At[m][k], acc[ai][bj][m][n], 0, 0, 0); } \
        __builtin_amdgcn_s_setprio(0); } while (0)
#define PG8_WAIT_V(n) asm volatile("s_waitcnt vmcnt(" #n ")" ::: "memory")
#define PG8_WAIT_L(n) asm volatile("s_waitcnt lgkmcnt(" #n ")" ::: "memory")
#define PG8_BAR __builtin_amdgcn_s_barrier()
#define PG8_SCHED __builtin_amdgcn_sched_barrier(0)
    Unit cur, nxt; int ui = 0;
    if (!S.next(0, cur)) return;
    f32x4 acc[2][2][4][2];
#pragma unroll
    for (int a = 0; a < 2; ++a)
#pragma unroll
        for (int b = 0; b < 2; ++b)
#pragma unroll
            for (int m = 0; m < 4; ++m)
#pragma unroll
                for (int n = 0; n < 2; ++n) acc[a][b][m][n] = (f32x4){0.f, 0.f, 0.f, 0.f};
    bf16x8 At[4][2], B0[2][2], B1[2][2]; v8i_t At8[4], B08[2], B18[2];
    const char* cA = (const char*)cur.A; const char* cB = (const char*)cur.B;
    PG8_STAGE(PG8_SB(0, 0), cB, voffB); PG8_STAGE(PG8_SB(0, 1), cB + hstepB, voffB); PG8_STAGE(PG8_SA(0, 0), cA, voffA); PG8_STAGE(PG8_SA(0, 1), cA + hstepA, voffA);
    if (wr == 1) PG8_BAR;
    PG8_WAIT_V(2); PG8_BAR;
    PG8_STAGE(PG8_SB(1, 0), cB + kstep, voffB); PG8_STAGE(PG8_SA(1, 0), cA + kstep, voffA); PG8_STAGE(PG8_SB(1, 1), cB + hstepB + kstep, voffB);
    PG8_WAIT_V(6); PG8_BAR;
    for (;;) {
        const bool has_next = S.next(ui + 1, nxt);
        const char* nA = has_next ? (const char*)nxt.A : cA; const char* nB = has_next ? (const char*)nxt.B : cB;
#pragma unroll 1
        for (int t = 0; t < nt; t += 2) {
            const bool last = (t == nt - 2);
            const char* a1 = cA + (size_t)(t + 1) * kstep;
            const char* a2 = last ? nA : cA + (size_t)(t + 2) * kstep; const char* b2 = last ? nB : cB + (size_t)(t + 2) * kstep;
            const char* a3 = a2 + kstep; const char* b3 = b2 + kstep;
            PG8_LDB(B0, 0, 0); PG8_LDB(B1, 0, 1); PG8_SCHED; PG8_LDA(At, 0, 0); PG8_STAGE(PG8_SA(1, 1), a1 + hstepA, voffA);
            PG8_WAIT_V(8); PG8_WAIT_L(0); PG8_BAR; PG8_MMA(0, 0, At, B0); PG8_MMA(0, 1, At, B1); PG8_BAR; PG8_SCHED;
            PG8_LDA(At, 0, 1); PG8_STAGE(PG8_SB(0, 0), b2, voffB); PG8_STAGE(PG8_SB(0, 1), b2 + hstepB, voffB); PG8_STAGE(PG8_SA(0, 0), a2, voffA);
            PG8_WAIT_V(8); PG8_WAIT_L(0); PG8_BAR; PG8_MMA(1, 0, At, B0); PG8_MMA(1, 1, At, B1); PG8_BAR; PG8_SCHED;
            PG8_LDB(B0, 1, 0); PG8_LDB(B1, 1, 1); PG8_SCHED; PG8_LDA(At, 1, 0); PG8_STAGE(PG8_SA(0, 1), a2 + hstepA, voffA);
            PG8_WAIT_V(8); PG8_WAIT_L(0); PG8_BAR; PG8_MMA(0, 0, At, B0); PG8_MMA(0, 1, At, B1); PG8_BAR; PG8_SCHED;
            PG8_LDA(At, 1, 1); PG8_STAGE(PG8_SB(1, 0), b3, voffB); PG8_STAGE(PG8_SB(1, 1), b3 + hstepB, voffB); PG8_STAGE(PG8_SA(1, 0), a3, voffA);
            PG8_WAIT_V(8); PG8_WAIT_L(0); PG8_BAR; PG8_MMA(1, 0, At, B0); PG8_MMA(1, 1, At, B1); PG8_BAR; PG8_SCHED;
        }
        if (wr == 0) PG8_BAR;
        if constexpr (Epi::FP8) asm volatile("s_nop 15\n\ts_nop 15" ::: "memory");
        if constexpr (!Epi::AFTER_DRAIN) E(acc, cur, wr, wc, fr, fq);
        if (!has_next) break;
        if (!Epi::CHAIN || cur.n == 2) {
#pragma unroll
            for (int a = 0; a < 2; ++a)
#pragma unroll
                for (int b = 0; b < 2; ++b)
#pragma unroll
                    for (int m = 0; m < 4; ++m)
#pragma unroll
                        for (int n = 0; n < 2; ++n) acc[a][b][m][n] = (f32x4){0.f, 0.f, 0.f, 0.f};
        }
        cur = nxt; cA = nA; cB = nB; ++ui;
        if (wr == 1) PG8_BAR;
    }
    PG8_WAIT_V(0);
    PG8_BAR;
    if constexpr (Epi::AFTER_DRAIN) E.fused(acc, cur, wr, wc, fr, fq, lds, wid, lane);
#undef PG8_SA
#undef PG8_SB
#undef PG8_STAGE
#undef PG8_LDA
#undef PG8_LDB
#undef PG8_MMA
#undef PG8_FA
#undef PG8_FB
#undef PG8_WAIT_V
#undef PG8_WAIT_L
#undef PG8_BAR
#undef PG8_SCHED
}
#define GEMM_PHASE(EpiT, SchedT, g, S, E) gemm_phase<EpiT, SchedT>((PG8_LAS unsigned char*)lds, g, S, E, my_wave)

struct Ctx {
    unsigned char* lds; int tid, lane, wave, gw, ngw;
};
struct TDesc { const float* W; bf16_t* WT; int K, N, mode, item; };
__device__ __forceinline__ void titem_load(const TDesc& d, int lane, f32x4 (&v)[8]) {
    const int nblk = d.N / 32, kb = d.item / nblk, nb = d.item % nblk, k0 = 64 * kb, n0 = 32 * nb;
#pragma unroll
    for (int i = 0; i < 8; ++i) v[i] = __builtin_nontemporal_load((const f32x4*)(d.W + (size_t)(k0 + 8 * i + (lane >> 3)) * d.N + n0 + 4 * (lane & 7)));
}
__device__ __forceinline__ void titem_store(const TDesc& d, int lane, const f32x4 (&v)[8], float* scr) {
    const int nblk = d.N / 32, kb = d.item / nblk, nb = d.item % nblk, k0 = 64 * kb, n0 = 32 * nb;
#pragma unroll
    for (int i = 0; i < 8; ++i) { float* q = scr + (8 * i + (lane >> 3)) * 33 + 4 * (lane & 7); q[0] = v[i][0]; q[1] = v[i][1]; q[2] = v[i][2]; q[3] = v[i][3]; }
    __builtin_amdgcn_wave_barrier(); asm volatile("s_waitcnt lgkmcnt(0)" ::: "memory");
    int d0 = n0;
    if (d.mode == 1) { const int half = d.N / 2; const int j = (n0 < half) ? n0 : n0 - half; d0 = (j / 128) * 256 + (j % 128) + ((n0 < half) ? 0 : 128); }
    const int c = lane & 7;
#pragma unroll
    for (int j = 0; j < 4; ++j) { const int n = (lane >> 3) + 8 * j; const float* sp = scr + (8 * c) * 33 + n;
        if (d.mode == 2) {
            u32x2 o; o.x = pk4_fp8(sp[0 * 33] * WG8_SCALE, sp[1 * 33] * WG8_SCALE, sp[2 * 33] * WG8_SCALE, sp[3 * 33] * WG8_SCALE); o.y = pk4_fp8(sp[4 * 33] * WG8_SCALE, sp[5 * 33] * WG8_SCALE, sp[6 * 33] * WG8_SCALE, sp[7 * 33] * WG8_SCALE);
            *(u32x2*)((unsigned char*)d.WT + (size_t)(d0 - d.N / 2 + n) * d.K + k0 + 8 * c) = o; continue; }
        u32x4 o; o.x = pk2(sp[0 * 33], sp[1 * 33]); o.y = pk2(sp[2 * 33], sp[3 * 33]); o.z = pk2(sp[4 * 33], sp[5 * 33]); o.w = pk2(sp[6 * 33], sp[7 * 33]);
        *(u32x4*)(d.WT + (size_t)(d0 + n) * d.K + k0 + 8 * c) = o; }
    __builtin_amdgcn_wave_barrier(); asm volatile("s_waitcnt lgkmcnt(0)" ::: "memory");
}
struct MixerW { const float *w_in, *w_branch, *w_out, *pool_w; unsigned char* ws;
    static constexpr int I_IN = 16 * 192, I_B = 8 * 32, I_O = 16 * 32, I_P = 2 * 4, NIT = I_IN + 3 * I_B + I_O + 4 * I_P;
    __device__ __forceinline__ TDesc desc(int it) const {
        int r = it;
        if (r < I_IN) { const bool gate = (r % 192) >= 96;
            return TDesc{w_in, (bf16_t*)(ws + (gate ? WS_WG8 : WS_WIN)), 1024, IN_TOTAL, gate ? 2 : 0, r}; }
        r -= I_IN;
        if (r < 3 * I_B) { const int n = r / I_B; return TDesc{w_branch + (size_t)n * 512 * 1024, (bf16_t*)(ws + WS_WB) + (size_t)n * 1024 * 512, 512, 1024, 0, r % I_B}; }
        r -= 3 * I_B;
        if (r < I_O) return TDesc{w_out, (bf16_t*)(ws + WS_WOUT), 1024, 1024, 0, r};
        r -= I_O;
        { const int g = r / I_P; return TDesc{pool_w + (size_t)g * 128 * 128, (bf16_t*)(ws + WS_WPOOL) + (size_t)g * 128 * 128, 128, 128, 0, r % I_P}; }
    }
};
struct FfnW { const float *w1, *w2; unsigned char* ws;
    static constexpr int I_1 = 16 * 176, I_2 = 44 * 32, NIT = I_1 + I_2;
    __device__ __forceinline__ TDesc desc(int it) const {
        if (it < I_1) return TDesc{w1, (bf16_t*)(ws + WS_WF1), 1024, 2 * DFF, 1, it};
        return TDesc{w2, (bf16_t*)(ws + WS_WF2), DFF, 1024, 0, it - I_1};
    }
};
template <class Wset>
__device__ __forceinline__ void convert_weights(const Ctx& C, const Wset& ww) {
    float* scr = (float*)(C.lds + C.wave * 16384);
    int it = C.gw; if (it >= Wset::NIT) return;
    TDesc d = ww.desc(it); f32x4 v[8]; titem_load(d, C.lane, v);
#pragma unroll 1
    for (;;) {
        const int nx = it + C.ngw; const bool hn = nx < Wset::NIT;
        TDesc dn = d; f32x4 vn[8];
        if (hn) { dn = ww.desc(nx); titem_load(dn, C.lane, vn); }
        titem_store(d, C.lane, v, scr);
        if (!hn) break;
        d = dn; it = nx;
#pragma unroll
        for (int i = 0; i < 8; ++i) v[i] = vn[i];
    }
}
__device__ __forceinline__ void convert_mixer_weights(const Ctx& C, const float* w_in, const float* w_branch, const float* w_out, const float* pool_w, unsigned char* ws) {
    convert_weights(C, MixerW{w_in, w_branch, w_out, pool_w, ws});
}
__device__ __forceinline__ void convert_ffn_weights(const Ctx& C, const float* w1, const float* w2, unsigned char* ws) {
    convert_weights(C, FfnW{w1, w2, ws});
}
__device__ __forceinline__ void rms_rows4_to_bf16(const float* x, const float* g, bf16_t* h, unsigned char* h8, int m0, int mstep, int lane) {
    f32x4 v[4][4]; float ss[4];
#pragma unroll
    for (int r = 0; r < 4; ++r) { const int m = m0 + r * mstep; const bool ok = m < MTOK; ss[r] = 0.f;
#pragma unroll
        for (int j = 0; j < 4; ++j) { v[r][j] = ok ? *((const f32x4*)(x + (size_t)m * DM) + lane + 64 * j) : (f32x4){0.f, 0.f, 0.f, 0.f}; } }
#pragma unroll
    for (int r = 0; r < 4; ++r) {
#pragma unroll
        for (int j = 0; j < 4; ++j) ss[r] += (v[r][j][0] * v[r][j][0] + v[r][j][1] * v[r][j][1]) + (v[r][j][2] * v[r][j][2] + v[r][j][3] * v[r][j][3]);
        ss[r] = wave_sum(ss[r]); }
#pragma unroll
    for (int r = 0; r < 4; ++r) { const int m = m0 + r * mstep; if (m >= MTOK) continue;
        const float rstd = 1.0f / sqrtf(ss[r] * (1.f / DM) + EPS);
#pragma unroll
        for (int j = 0; j < 4; ++j) { const f32x4 gg = *((const f32x4*)g + lane + 64 * j); const f32x4 o = v[r][j] * rstd * gg;
            u32x2 w; w.x = pk2(o[0], o[1]); w.y = pk2(o[2], o[3]); *((u32x2*)(h + (size_t)m * DM) + lane + 64 * j) = w;
            *((unsigned*)(h8 + (size_t)m * DM) + lane + 64 * j) = pk4_fp8(o[0], o[1], o[2], o[3]); } }
}
__device__ __forceinline__ void rms_row_to_bf16(const float* xrow, const float* g, bf16_t* hrow, int lane) {
    f32x4 v[4]; float ss = 0.f;
#pragma unroll
    for (int j = 0; j < 4; ++j) { v[j] = *((const f32x4*)xrow + lane + 64 * j); ss += (v[j][0] * v[j][0] + v[j][1] * v[j][1]) + (v[j][2] * v[j][2] + v[j][3] * v[j][3]); }
    const float rstd = 1.0f / sqrtf(wave_sum(ss) * (1.f / DM) + EPS);
#pragma unroll
    for (int j = 0; j < 4; ++j) { const f32x4 gg = *((const f32x4*)g + lane + 64 * j); const f32x4 o = v[j] * rstd * gg;
        u32x2 w; w.x = pk2(o[0], o[1]); w.y = pk2(o[2], o[3]); *((u32x2*)hrow + lane + 64 * j) = w; }
}
__device__ __forceinline__ void res_norm_row(const float* orow, const float* xin, float* xout, const float* gpost, const float* gnext, bf16_t* hrow, unsigned char* h8row, int lane) {
    f32x4 o[4], x[4]; float ss = 0.f;
#pragma unroll
    for (int j = 0; j < 4; ++j) { o[j] = *((const f32x4*)orow + lane + 64 * j); x[j] = *((const f32x4*)xin + lane + 64 * j); ss += (o[j][0] * o[j][0] + o[j][1] * o[j][1]) + (o[j][2] * o[j][2] + o[j][3] * o[j][3]); }
    const float rstd = 1.0f / sqrtf(wave_sum(ss) * (1.f / DM) + EPS);
    float s2 = 0.f;
#pragma unroll
    for (int j = 0; j < 4; ++j) { const f32x4 gg = *((const f32x4*)gpost + lane + 64 * j); x[j] = x[j] + o[j] * rstd * gg; *((f32x4*)xout + lane + 64 * j) = x[j];
        s2 += (x[j][0] * x[j][0] + x[j][1] * x[j][1]) + (x[j][2] * x[j][2] + x[j][3] * x[j][3]); }
    if (gnext) {
        const float r2 = 1.0f / sqrtf(wave_sum(s2) * (1.f / DM) + EPS);
#pragma unroll
        for (int j = 0; j < 4; ++j) { const f32x4 gg = *((const f32x4*)gnext + lane + 64 * j); const f32x4 h = x[j] * r2 * gg;
            u32x2 w; w.x = pk2(h[0], h[1]); w.y = pk2(h[2], h[3]); *((u32x2*)hrow + lane + 64 * j) = w;
            if (h8row) *((unsigned*)h8row + lane + 64 * j) = pk4_fp8(h[0], h[1], h[2], h[3]); }
    }
}

constexpr int LP = 136;
template <bool CAUSAL>
__device__ __forceinline__ void mm128(const bf16_t* Pl, const bf16_t* Ql, int w, int r, int q, f32x4 (&acc)[8]) {
#pragma unroll
    for (int rb = 0; rb < 8; ++rb) acc[rb] = (f32x4){0.f, 0.f, 0.f, 0.f};
#pragma unroll
    for (int kb = 0; kb < 4; ++kb) {
        const bf16x8 p = *(const bf16x8*)(Pl + (16 * w + r) * LP + 32 * kb + 8 * q);
#pragma unroll
        for (int rb = 0; rb < 8; ++rb) {
            if (CAUSAL && rb < 2 * kb) continue;
            const bf16x8 qq = *(const bf16x8*)(Ql + (16 * rb + r) * LP + 32 * kb + 8 * q);
            acc[rb] = __builtin_amdgcn_mfma_f32_16x16x32_bf16(p, qq, acc[rb], 0, 0, 0);
        }
    }
}
__device__ __forceinline__ void unpack8(const u32x4 raw, float (&x)[8]) { x[0] = bflo(raw.x); x[1] = bfhi(raw.x); x[2] = bflo(raw.y); x[3] = bfhi(raw.y); x[4] = bflo(raw.z); x[5] = bfhi(raw.z); x[6] = bflo(raw.w); x[7] = bfhi(raw.w); }
__device__ __forceinline__ void gmlp_unit(const Ctx& C, int unit, bf16_t* ZA, const float* ln_g, const float* ln_b, const float* w_s, const float* b_s) {
    const int g = unit & 3, bc = unit >> 2; const size_t row0 = (size_t)bc * 128;
    float* stats = (float*)C.lds;
    bf16_t* vnT = (bf16_t*)(C.lds + 1024);
    bf16_t* wsL = (bf16_t*)(C.lds + 1024 + 128 * LP * 2);
    float* part = (float*)(C.lds + 1024 + 2 * 128 * LP * 2);
    const int w = C.wave, lane = C.lane, r = lane & 15, q = lane >> 4;
    u32x4 raw[2][8], fv[2][2]; u32x2 uw[8]; float bs[8];
#pragma unroll
    for (int h = 0; h < 2; ++h) { const int s = lane + 64 * h; const u32x4* vp = (const u32x4*)(ZA + (row0 + s) * 1024 + 512 + 64 * w);
#pragma unroll
        for (int k = 0; k < 8; ++k) raw[h][k] = vp[k];
        const u32x4* fp = (const u32x4*)(ZA + (row0 + s) * 1024 + 512 + g * 128 + 16 * w); fv[h][0] = fp[0]; fv[h][1] = fp[1]; }
#pragma unroll
    for (int tb = 0; tb < 8; ++tb) { const int t = 16 * tb + r; bs[tb] = b_s[g * 128 + t]; uw[tb] = *(const u32x2*)(ZA + (row0 + t) * 1024 + g * 128 + 16 * w + 4 * q); }
#pragma unroll
    for (int h = 0; h < 2; ++h) { const int s = lane + 64 * h;
        float s1 = 0.f, s2 = 0.f;
#pragma unroll
        for (int k = 0; k < 8; ++k) { float x[8]; unpack8(raw[h][k], x);
#pragma unroll
            for (int e = 0; e < 8; ++e) { s1 += x[e]; s2 += x[e] * x[e]; } }
        *(f32x2*)(part + (w * 128 + s) * 2) = (f32x2){s1, s2}; }
#pragma unroll
    for (int j = 0; j < 8; ++j) { const int idx = C.tid * 4 + 2048 * j, t = idx >> 7, s = idx & 127; const f32x4 v = *(const f32x4*)(w_s + (size_t)g * 128 * 128 + idx);
        u32x2 o; o.x = pk2(s <= t ? v[0] : 0.f, s + 1 <= t ? v[1] : 0.f); o.y = pk2(s + 2 <= t ? v[2] : 0.f, s + 3 <= t ? v[3] : 0.f);
        *(u32x2*)(wsL + t * LP + s) = o; }
    __syncthreads();
    if (C.tid < 128) { float s1 = 0.f, s2 = 0.f;
#pragma unroll
        for (int k = 0; k < 8; ++k) { const f32x2 p = *(const f32x2*)(part + (k * 128 + C.tid) * 2); s1 += p[0]; s2 += p[1]; }
        const float mean = s1 * (1.f / 512.f), var = fmaxf(s2 * (1.f / 512.f) - mean * mean, 0.f);
        *(f32x2*)(stats + 2 * C.tid) = (f32x2){mean, 1.0f / sqrtf(var + EPS)}; }
    __syncthreads();
    f32x4 gm[4], bt[4];
#pragma unroll
    for (int k = 0; k < 4; ++k) { gm[k] = *(const f32x4*)(ln_g + g * 128 + 16 * w + 4 * k); bt[k] = *(const f32x4*)(ln_b + g * 128 + 16 * w + 4 * k); }
#pragma unroll
    for (int h = 0; h < 2; ++h) { const int s = lane + 64 * h; const f32x2 st = *(const f32x2*)(stats + 2 * s);
        float x[16]; { float a[8], b[8]; unpack8(fv[h][0], a); unpack8(fv[h][1], b);
#pragma unroll
            for (int e = 0; e < 8; ++e) { x[e] = a[e]; x[8 + e] = b[e]; } }
#pragma unroll
        for (int j = 0; j < 16; ++j) vnT[(16 * w + j) * LP + s] = (bf16_t)f2bf((x[j] - st[0]) * st[1] * gm[j >> 2][j & 3] + bt[j >> 2][j & 3]); }
    __syncthreads();
    f32x4 acc[8];
    mm128<true>(vnT, wsL, w, r, q, acc);
#pragma unroll
    for (int tb = 0; tb < 8; ++tb) { const int t = 16 * tb + r;
        u32x2 o; o.x = pk2(bflo(uw[tb].x) * (acc[tb][0] + bs[tb]), bfhi(uw[tb].x) * (acc[tb][1] + bs[tb])); o.y = pk2(bflo(uw[tb].y) * (acc[tb][2] + bs[tb]), bfhi(uw[tb].y) * (acc[tb][3] + bs[tb]));
        *(u32x2*)(ZA + (row0 + t) * 1024 + g * 128 + 16 * w + 4 * q) = o; }
    __syncthreads();
}
template <int W>
__device__ __forceinline__ void pool_fill(const bf16_t* ZCg, int row0, int tid, bf16_t* pl) {
    const int c8 = tid & 15, s0 = 4 * (tid >> 4); const int rowb = row0 + s0, t0 = rowb & (SEQ - 1);
    u32x4 raw[W + 3];
#pragma unroll
    for (int k = 0; k < W + 3; ++k) { const int dt = k - (W - 1);
        raw[k] = (t0 + dt >= 0) ? *(const u32x4*)(ZCg + (size_t)(rowb + dt) * 512 + 8 * c8) : (u32x4){0u, 0u, 0u, 0u}; }
    float sum[8] = {0.f, 0.f, 0.f, 0.f, 0.f, 0.f, 0.f, 0.f};
#pragma unroll
    for (int k = 0; k < W; ++k) { float x[8]; unpack8(raw[k], x);
#pragma unroll
        for (int e = 0; e < 8; ++e) sum[e] += x[e]; }
#pragma unroll
    for (int j = 0; j < 4; ++j) { float self[8]; unpack8(raw[j + W - 1], self);
        if (j > 0) { float old[8]; unpack8(raw[j - 1], old);
#pragma unroll
            for (int e = 0; e < 8; ++e) sum[e] += self[e] - old[e]; }
        const int cnt = (t0 + j + 1 < W) ? t0 + j + 1 : W; const float inv = 1.0f / (float)cnt;
        u32x4 o; o.x = pk2(sum[0] * inv - self[0], sum[1] * inv - self[1]); o.y = pk2(sum[2] * inv - self[2], sum[3] * inv - self[3]);
        o.z = pk2(sum[4] * inv - self[4], sum[5] * inv - self[5]); o.w = pk2(sum[6] * inv - self[6], sum[7] * inv - self[7]);
        *(u32x4*)(pl + (s0 + j) * LP + 8 * c8) = o; }
}
__device__ __forceinline__ void pool_unit(const Ctx& C, int unit, const bf16_t* ZC, const bf16_t* WpT, const float* pool_scale, bf16_t* YC) {
    const int g = unit & 3, tile = unit >> 2; const int row0 = tile * 128;
    bf16_t* pl = (bf16_t*)(C.lds + 1024);
    bf16_t* wl = (bf16_t*)(C.lds + 1024 + 128 * LP * 2);
    const int w = C.wave, lane = C.lane;
    if (g == 0) pool_fill<2>(ZC + g * 128, row0, C.tid, pl); else if (g == 1) pool_fill<4>(ZC + g * 128, row0, C.tid, pl);
    else if (g == 2) pool_fill<8>(ZC + g * 128, row0, C.tid, pl); else pool_fill<16>(ZC + g * 128, row0, C.tid, pl);
#pragma unroll
    for (int j = 0; j < 4; ++j) { const int idx = C.tid + 512 * j, d = idx >> 4, c16 = idx & 15;
        *(u32x4*)(wl + d * LP + 8 * c16) = *(const u32x4*)(WpT + (size_t)g * 128 * 128 + d * 128 + 8 * c16); }
    __syncthreads();
    const int r = lane & 15, q = lane >> 4;
    f32x4 acc[8];
    mm128<false>(wl, pl, w, r, q, acc);
    const f32x4 ps = *(const f32x4*)(pool_scale + g * 128 + 16 * w + 4 * q);
#pragma unroll
    for (int sb = 0; sb < 8; ++sb) { const int s = 16 * sb + r;
        u32x2 o; o.x = pk2(acc[sb][0] * ps[0], acc[sb][1] * ps[1]); o.y = pk2(acc[sb][2] * ps[2], acc[sb][3] * ps[3]);
        *(u32x2*)(YC + (size_t)(row0 + s) * 1024 + 512 + g * 128 + 16 * w + 4 * q) = o; }
    __syncthreads();
}
namespace attn_body {
using bf16=unsigned short;
using s16x4=__attribute__((ext_vector_type(4)))short;
using f32x16=__attribute__((ext_vector_type(16)))float;
constexpr int BATCH=8,SEQ=2048,D=64,DM=1536;
constexpr int NW=8,QBLK=32,QB=QBLK*NW,KVBLK=64,NQB=SEQ/QB;
__device__ __forceinline__ int crow(int r,int hi){return (r&3)+8*(r>>2)+4*hi;}
#define SBAR() __builtin_amdgcn_sched_barrier(0)
__device__ __forceinline__ void cmask(f32x16&p0,f32x16&p1,int jb,int qrel,int hi){
  const float NEG=-INFINITY; int kb=64*jb+4*hi;
  #pragma unroll
  for(int r=0;r<16;++r){int kv=kb+(r&3)+8*(r>>2); if(kv>qrel)p0[r]=NEG; if(kv+32>qrel)p1[r]=NEG;}
}

constexpr int NSLOT=3, SLOTB=8192;
constexpr int LDS_K=0, LDS_V=NSLOT*SLOTB, LDS_WS=2*NSLOT*SLOTB, LDS_OST=LDS_WS+NW*64*4, LDS_BYTES=LDS_OST+NW*8192;
constexpr float C2=0.125f*1.4426950408889634f;
__device__ __forceinline__ void glds16(const void*gsrc,unsigned lds_dst){unsigned keep;
  asm volatile("s_mov_b32 %0, m0\n\ts_mov_b32 m0, %2\n\ts_nop 0\n\tglobal_load_lds_dwordx4 %1, off\n\ts_mov_b32 m0, %0":"=&s"(keep):"v"(gsrc),"s"(lds_dst):"memory");}
__device__ __forceinline__ float max3f(float a,float b,float c){float r;asm("v_max3_f32 %0, %1, %2, %3":"=v"(r):"v"(a),"v"(b),"v"(c));return r;}
__device__ __forceinline__ float max2f(float a,float b){float r;asm("v_max_f32_e32 %0, %1, %2":"=v"(r):"v"(a),"v"(b));return r;}
__device__ __forceinline__ float fadd_s(float a,float b){float r;asm("v_add_f32_e32 %0, %1, %2":"=v"(r):"v"(a),"v"(b));return r;}
__device__ __forceinline__ float fsub_s(float a,float b){float r;asm("v_sub_f32_e32 %0, %1, %2":"=v"(r):"v"(a),"v"(b));return r;}
typedef float f32x2_t __attribute__((ext_vector_type(2))); typedef __bf16 bf16x2_t __attribute__((ext_vector_type(2)));
__device__ __forceinline__ unsigned cvtpk_s(float lo,float hi){f32x2_t v={lo,hi};bf16x2_t b=__builtin_convertvector(v,bf16x2_t);return __builtin_bit_cast(unsigned,b);}
#define WAIT_BAR(N) asm volatile("s_waitcnt vmcnt(" #N ") lgkmcnt(0)\n\ts_barrier":::"memory")

__device__ __forceinline__ void qkt(f32x16&p0,f32x16&p1,const char*Kslot,const bf16x8*qr,const f32x16&negm,int r32,int hi){
  const char*kb=Kslot+hi*1024+r32*16;
  #pragma unroll
  for(int d0=0;d0<4;++d0){
    const bf16x8 b0=*reinterpret_cast<const bf16x8*>(kb+d0*2048);
    const bf16x8 b1=*reinterpret_cast<const bf16x8*>(kb+d0*2048+512);
    if(d0==0){p0=__builtin_amdgcn_mfma_f32_32x32x16_bf16(b0,qr[0],negm,0,0,0);p1=__builtin_amdgcn_mfma_f32_32x32x16_bf16(b1,qr[0],negm,0,0,0);}
    else{p0=__builtin_amdgcn_mfma_f32_32x32x16_bf16(b0,qr[d0],p0,0,0,0);p1=__builtin_amdgcn_mfma_f32_32x32x16_bf16(b1,qr[d0],p1,0,0,0);}}
}
typedef __attribute__((address_space(3))) const char* lds_cptr;
typedef short v4i16_t __attribute__((ext_vector_type(4)));
__device__ __forceinline__ void kload8(bf16x8*kf,lds_cptr kp){
  kf[0]=*(const __attribute__((address_space(3))) bf16x8*)(kp);      kf[1]=*(const __attribute__((address_space(3))) bf16x8*)(kp+512);
  kf[2]=*(const __attribute__((address_space(3))) bf16x8*)(kp+2048); kf[3]=*(const __attribute__((address_space(3))) bf16x8*)(kp+2560);
  kf[4]=*(const __attribute__((address_space(3))) bf16x8*)(kp+4096); kf[5]=*(const __attribute__((address_space(3))) bf16x8*)(kp+4608);
  kf[6]=*(const __attribute__((address_space(3))) bf16x8*)(kp+6144); kf[7]=*(const __attribute__((address_space(3))) bf16x8*)(kp+6656);
}
__device__ __forceinline__ void kload2(bf16x8*kf,lds_cptr kp,int j){ kf[2*j]=*(const __attribute__((address_space(3))) bf16x8*)(kp+j*2048); kf[2*j+1]=*(const __attribute__((address_space(3))) bf16x8*)(kp+j*2048+512); }
__device__ __forceinline__ s16x4 vtr(lds_cptr p){ return __builtin_bit_cast(s16x4,__builtin_amdgcn_ds_read_tr16_b64_v4i16((__attribute__((address_space(3))) v4i16_t*)p)); }
__device__ __forceinline__ float rowmax(const f32x16&p0,const f32x16&p1){
  float a=max3f(p0[0],p0[1],p1[0]),b=max3f(p0[2],p0[3],p1[1]);a=max3f(a,p1[2],p1[3]);
  #pragma unroll
  for(int r=4;r<16;r+=4){a=max3f(a,p0[r],p0[r+1]);b=max3f(b,p0[r+2],p0[r+3]);a=max3f(a,p1[r],p1[r+1]);b=max3f(b,p1[r+2],p1[r+3]);}
  const float m=max2f(a,b);
  auto rr=__builtin_amdgcn_permlane32_swap(__float_as_uint(m),__float_as_uint(m),false,false);
  return max2f(__uint_as_float(rr[0]),__uint_as_float(rr[1]));
}
__device__ __forceinline__ void pv(f32x16*o,int vb,bf16x8 pa0,bf16x8 pa1,bf16x8 pa2,bf16x8 pa3){
  #pragma unroll
  for(int d0=0;d0<2;++d0){s16x4 lo[4],hi[4];
    #pragma unroll
    for(int ks=0;ks<4;++ks){
      asm volatile("ds_read_b64_tr_b16 %0,%1 offset:%c2":"=&v"(lo[ks]):"v"(vb),"i"(d0*4096+ks*1024):"memory");
      asm volatile("ds_read_b64_tr_b16 %0,%1 offset:%c2":"=&v"(hi[ks]):"v"(vb),"i"(d0*4096+ks*1024+512):"memory");}
    asm volatile("s_waitcnt lgkmcnt(0)":::"memory");SBAR();
    #define PK(k) (bf16x8){lo[k][0],lo[k][1],lo[k][2],lo[k][3],hi[k][0],hi[k][1],hi[k][2],hi[k][3]}
    o[d0]=__builtin_amdgcn_mfma_f32_32x32x16_bf16(pa0,PK(0),o[d0],0,0,0);
    o[d0]=__builtin_amdgcn_mfma_f32_32x32x16_bf16(pa1,PK(1),o[d0],0,0,0);
    o[d0]=__builtin_amdgcn_mfma_f32_32x32x16_bf16(pa2,PK(2),o[d0],0,0,0);
    o[d0]=__builtin_amdgcn_mfma_f32_32x32x16_bf16(pa3,PK(3),o[d0],0,0,0);
    #undef PK
  }
}

#ifndef ATTN_STORE16
#define ATTN_STORE16(p,v) (*(u32x4*)(p)=(v))
#endif
template<int THRL> __device__ __forceinline__ void attn_unit(int b,int qb,const bf16*Q,const bf16*__restrict__ K,const bf16*__restrict__ V,int c,int vh,float lam,char*shm,int wave_){
  const int tid=fresh_tid(wave_),lane=tid&63,r32=lane&31,hi=lane>>5; const int wid=__builtin_amdgcn_readfirstlane(tid>>6);
  const long rowbase=(long)b*SEQ; const int q0=qb*QB;
  const bf16*Qw=Q+(rowbase+q0+wid*QBLK)*DM;
  const bf16*Kh=K+rowbase*DM,*Vh=V+rowbase*DM;
  const unsigned lds0=(unsigned)(uintptr_t)shm;
  float*wsf=(float*)(shm+LDS_WS)+wid*64;
  const bf16*ksrc=Kh+(long)lane*DM+wid*8;
  const bf16*vsrc=Vh+(long)(16*(wid&3)+(lane>>2))*DM+(wid>>2)*32+(lane&3)*8;
  const unsigned kdst=lds0+LDS_K+wid*1024, vdst=lds0+LDS_V+wid*1024;
  #define DMA_K(t,slot) glds16(ksrc+(long)(t)*KVBLK*DM,(unsigned)__builtin_amdgcn_readfirstlane(kdst+(slot)))
  #define DMA_V(t,slot) glds16(vsrc+(long)(t)*KVBLK*DM,(unsigned)__builtin_amdgcn_readfirstlane(vdst+(slot)))
  const int vb0=(int)(lds0+LDS_V)+((lane>>4)&1)*32+(lane&3)*8+(4*hi+((lane&15)>>2))*64;
  const char*Kbase=shm+LDS_K; bf16x8 kf[8];
  const lds_cptr shm3=(lds_cptr)shm; const lds_cptr kp0=shm3+LDS_K+hi*1024+r32*16; const lds_cptr vp0=shm3+LDS_V+((lane>>4)&1)*32+(lane&3)*8+(4*hi+((lane&15)>>2))*64;
  const int NT=(q0+QB)/KVBLK;
  DMA_K(0,0);DMA_V(0,0);DMA_K(1,SLOTB);
  bf16x8 qr[4];
  #pragma unroll
  for(int d0=0;d0<4;++d0)qr[d0]=*reinterpret_cast<const bf16x8*>(&Qw[(long)r32*DM+d0*16+hi*8]);
  float mhat=0.f,l_reg=0.f;f32x16 o[2];o[0]=f32x16{};o[1]=f32x16{};f32x16 negm=f32x16{};asm volatile("":"+v"(negm));
  const int qrel=wid*QBLK+r32;
  #define CMASK(P0,P1,t) do{int jb_=(t)-(NT-4); if(jb_>=0)cmask(P0,P1,jb_,qrel,hi);}while(0)
  bool resc=false;
  #define START(P0,P1) do{ const float rm=rowmax(P0,P1); resc=false; \
    { const float dl=rm; mhat=fadd_s(mhat,dl); \
      _Pragma("unroll") for(int r=0;r<16;++r){P0[r]=fsub_s(P0[r],dl);P1[r]=fsub_s(P1[r],dl);} \
      _Pragma("unroll") for(int r=0;r<16;++r)negm[r]=-mhat; asm volatile("":"+v"(negm)); } \
    _Pragma("unroll") for(int r=0;r<16;++r)P0[r]=__builtin_amdgcn_exp2f(P0[r]); }while(0)
  #define RESC() do{ if(resc){ asm volatile("s_waitcnt lgkmcnt(0)":::"memory"); \
      _Pragma("unroll") for(int d_=0;d_<2;++d_) _Pragma("unroll") for(int r=0;r<16;++r)o[d_][r]*=wsf[crow(r,hi)]; } }while(0)
  f32x16 pA0,pA1,pB0,pB1;
  int sl_prev=0,sl_cur=0,sl_next=SLOTB;
  #define ROT() do{sl_prev=sl_cur;sl_cur=sl_next;sl_next=(sl_next==(NSLOT-1)*SLOTB)?0:sl_next+SLOTB;}while(0)
  DMA_K(2,2*SLOTB);
  WAIT_BAR(3);
  qkt(pA0,pA1,Kbase,qr,negm,r32,hi);asm volatile("s_nop 15\n\ts_nop 7":"+v"(pA0),"+v"(pA1));CMASK(pA0,pA1,0);
  START(pA0,pA1);
  _Pragma("unroll") for(int r=0;r<16;++r)pA1[r]=__builtin_amdgcn_exp2f(pA1[r]);
  WAIT_BAR(0);
  DMA_K(3,0);DMA_V(1,SLOTB);
  ROT();
  kload8(kf,kp0+sl_cur);
  WAIT_BAR(2);
  s16x4 vlo[8],vhi[8]; u32x4 pw0,pw1,pw2,pw3;
  #define PKW(P,B) cvtpk_s(P[B],P[B+1])
  #define PAF(k) __builtin_bit_cast(bf16x8,pw##k)
  #define VFR(i) (bf16x8){vlo[i][0],vlo[i][1],vlo[i][2],vlo[i][3],vhi[i][0],vhi[i][1],vhi[i][2],vhi[i][3]}
  #define PIN(x) asm volatile("":"+v"(x))
  #define MX3(a,b,c) __builtin_fmaxf(__builtin_fmaxf((a),(b)),(c))
  #define GAPA(MF,A0,A1,A2,A3,W0,W1,PW) do{ MF; sacc+=A0; sacc+=A1; sacc+=A2; sacc+=A3; PIN(sacc); W0; W1; PIN(PW); SBAR(); }while(0)
  #define EX(v) __builtin_amdgcn_exp2f(v)
  #define GAPB(MF,X,B) do{ MF; X[B]=EX(X[B]); X[B+1]=EX(X[B+1]); X[B+2]=EX(X[B+2]); X[B+3]=EX(X[B+3]); PIN(X); SBAR(); }while(0)
  #define VRD(i) do{ vlo[i]=vtr(vp_+(((i)>>2)*4096+((i)&3)*1024)); vhi[i]=vtr(vp_+(((i)>>2)*4096+((i)&3)*1024+512)); }while(0)
  #define KRD(G,j) do{ if(G){ kload2(kf,kp0+sl_next,j); SBAR(); } }while(0)
  #define STEP(C0,C1,P0,P1,t,GK,GV,GL) do{ SBAR(); \
    const lds_cptr vp_=vp0+sl_prev; \
    VRD(0); SBAR(); float sacc=(P0[0]+P0[1]); \
    GAPA(C0=__builtin_amdgcn_mfma_f32_32x32x16_bf16(kf[0],qr[0],negm,0,0,0), P0[2],P0[3],P0[4],P0[5],     pw0[0]=PKW(P0,0), pw0[1]=PKW(P0,2), pw0); \
    VRD(4); SBAR(); GAPA(C1=__builtin_amdgcn_mfma_f32_32x32x16_bf16(kf[1],qr[0],negm,0,0,0), P0[6],P0[7],P0[8],P0[9],     pw0[2]=PKW(P0,4), pw0[3]=PKW(P0,6), pw0); \
    VRD(1); SBAR(); GAPA(C0=__builtin_amdgcn_mfma_f32_32x32x16_bf16(kf[2],qr[1],C0,0,0,0),   P0[10],P0[11],P0[12],P0[13], pw1[0]=PKW(P0,8), pw1[1]=PKW(P0,10), pw1); \
    VRD(5); SBAR(); GAPA(C1=__builtin_amdgcn_mfma_f32_32x32x16_bf16(kf[3],qr[1],C1,0,0,0),   P0[14],P0[15],P1[0],P1[1],   pw1[2]=PKW(P0,12),pw1[3]=PKW(P0,14), pw1); \
    VRD(2); SBAR(); GAPA(C0=__builtin_amdgcn_mfma_f32_32x32x16_bf16(kf[4],qr[2],C0,0,0,0),   P1[2],P1[3],P1[4],P1[5],     pw2[0]=PKW(P1,0), pw2[1]=PKW(P1,2), pw2); \
    VRD(6); SBAR(); GAPA(C1=__builtin_amdgcn_mfma_f32_32x32x16_bf16(kf[5],qr[2],C1,0,0,0),   P1[6],P1[7],P1[8],P1[9],     pw2[2]=PKW(P1,4), pw2[3]=PKW(P1,6), pw2); \
    VRD(3); SBAR(); GAPA(C0=__builtin_amdgcn_mfma_f32_32x32x16_bf16(kf[6],qr[3],C0,0,0,0),   P1[10],P1[11],P1[12],P1[13], pw3[0]=PKW(P1,8), pw3[1]=PKW(P1,10), pw3); \
    VRD(7); SBAR(); GAPA(C1=__builtin_amdgcn_mfma_f32_32x32x16_bf16(kf[7],qr[3],C1,0,0,0),   P1[14],P1[15],0.f,0.f,       pw3[2]=PKW(P1,12),pw3[3]=PKW(P1,14), pw3); \
    l_reg+=sacc; \
    if(GK){DMA_K((t)+3,sl_cur);} if(GV){DMA_V((t)+1,sl_next);} \
    CMASK(C0,C1,t); \
    { float a=MX3(C0[0],C0[1],C1[0]),b=MX3(C0[2],C0[3],C1[1]); a=MX3(a,C1[2],C1[3]); \
      _Pragma("unroll") for(int r=4;r<16;r+=4){a=MX3(a,C0[r],C0[r+1]);b=MX3(b,C0[r+2],C0[r+3]);a=MX3(a,C1[r],C1[r+1]);b=MX3(b,C1[r+2],C1[r+3]);} \
      float rm=__builtin_fmaxf(a,b); { auto rr=__builtin_amdgcn_permlane32_swap(__float_as_uint(rm),__float_as_uint(rm),false,false); rm=__builtin_fmaxf(__uint_as_float(rr[0]),__uint_as_float(rr[1])); } \
      resc=false; \
      if(__builtin_expect(__any(rm>(float)THRL),0)){ const float dl=__builtin_fmaxf(rm,0.f); mhat+=dl; \
        _Pragma("unroll") for(int r=0;r<16;++r){C0[r]-=dl;C1[r]-=dl;} \
        _Pragma("unroll") for(int r=0;r<16;++r)negm[r]=-mhat; asm volatile("":"+v"(negm)); \
        const float f=__builtin_amdgcn_exp2f(-dl); l_reg*=f; if(hi==0)wsf[r32]=f; resc=true; } } \
    SBAR(); \
    GAPB(o[0]=__builtin_amdgcn_mfma_f32_32x32x16_bf16(PAF(0),VFR(0),o[0],0,0,0), C0,0); \
    GAPB(o[1]=__builtin_amdgcn_mfma_f32_32x32x16_bf16(PAF(0),VFR(4),o[1],0,0,0), C0,4); \
    KRD(GL,0); GAPB(o[0]=__builtin_amdgcn_mfma_f32_32x32x16_bf16(PAF(1),VFR(1),o[0],0,0,0), C0,8); \
    KRD(GL,1); GAPB(o[1]=__builtin_amdgcn_mfma_f32_32x32x16_bf16(PAF(1),VFR(5),o[1],0,0,0), C0,12); \
    KRD(GL,2); GAPB(o[0]=__builtin_amdgcn_mfma_f32_32x32x16_bf16(PAF(2),VFR(2),o[0],0,0,0), C1,0); \
    KRD(GL,3); GAPB(o[1]=__builtin_amdgcn_mfma_f32_32x32x16_bf16(PAF(2),VFR(6),o[1],0,0,0), C1,4); \
    GAPB(o[0]=__builtin_amdgcn_mfma_f32_32x32x16_bf16(PAF(3),VFR(3),o[0],0,0,0), C1,8); \
    GAPB(o[1]=__builtin_amdgcn_mfma_f32_32x32x16_bf16(PAF(3),VFR(7),o[1],0,0,0), C1,12); \
    }while(0)
  int t=1;
  #undef CMASK
  #define CMASK(P0,P1,t) do{}while(0)
  for(;t+5<NT;t+=2){
    STEP(pB0,pB1,pA0,pA1,t,true,true,true);     WAIT_BAR(2); RESC(); ROT();
    STEP(pA0,pA1,pB0,pB1,t+1,true,true,true);   WAIT_BAR(2); RESC(); ROT();
  }
  #undef CMASK
  #define CMASK(P0,P1,t) do{int jb_=(t)-(NT-4); if(jb_>=0)cmask(P0,P1,jb_,qrel,hi);}while(0)
  #define ENDW(tt) do{ if((tt)+3<NT){WAIT_BAR(2);} else if((tt)+2<NT){WAIT_BAR(1);} else {WAIT_BAR(0);} }while(0)
  for(;t+1<NT;t+=2){
    STEP(pB0,pB1,pA0,pA1,t,(t+3<NT),(t+1<NT),(t+1<NT));       ENDW(t);   RESC(); ROT();
    STEP(pA0,pA1,pB0,pB1,t+1,(t+4<NT),(t+2<NT),(t+2<NT));     ENDW(t+1); RESC(); ROT();
  }
  STEP(pB0,pB1,pA0,pA1,NT-1,false,false,false); RESC();
  { float sacc=pB0[0]+pB0[1]; _Pragma("unroll") for(int r=2;r<16;++r)sacc+=pB0[r]; _Pragma("unroll") for(int r=0;r<16;++r)sacc+=pB1[r]; l_reg+=sacc;
    pw0=(u32x4){PKW(pB0,0),PKW(pB0,2),PKW(pB0,4),PKW(pB0,6)};pw1=(u32x4){PKW(pB0,8),PKW(pB0,10),PKW(pB0,12),PKW(pB0,14)};pw2=(u32x4){PKW(pB1,0),PKW(pB1,2),PKW(pB1,4),PKW(pB1,6)};pw3=(u32x4){PKW(pB1,8),PKW(pB1,10),PKW(pB1,12),PKW(pB1,14)};
    SBAR(); pv(o,vb0+sl_cur,PAF(0),PAF(1),PAF(2),PAF(3)); }
  #undef PKW
  #undef PAF
  #undef VFR
  #undef PIN
  #undef MX3
  #undef GAPA
  #undef GAPB
  #undef EX
  #undef VRD
  #undef KRD
  #undef STEP
  #undef ENDW
  {auto rr=__builtin_amdgcn_permlane32_swap(__float_as_uint(l_reg),__float_as_uint(l_reg),false,false);l_reg=__uint_as_float(rr[0])+__uint_as_float(rr[1]);}
  if(hi==0)wsf[32+r32]=l_reg;asm volatile("s_waitcnt lgkmcnt(0)":::"memory");
  float rli[16];
  #pragma unroll
  for(int r=0;r<16;++r)rli[r]=__builtin_amdgcn_rcpf(wsf[32+crow(r,hi)]);
  { bf16*stg=(bf16*)(shm+LDS_OST)+wid*4096;
    if(c==0){
      #pragma unroll
      for(int r=0;r<16;++r){const int orow=crow(r,hi);
        #pragma unroll
        for(int d0=0;d0<2;++d0)stg[orow*128+vh*64+d0*32+r32]=(bf16)f2bf(o[d0][r]*rli[r]);}
    } else {
      #pragma unroll
      for(int r=0;r<16;++r){const int orow=crow(r,hi);
        #pragma unroll
        for(int d0=0;d0<2;++d0){bf16*p=stg+orow*128+vh*64+d0*32+r32; const float prev=__uint_as_float(((unsigned)*p)<<16); *p=(bf16)f2bf(prev-lam*(o[d0][r]*rli[r]));}}
    } }
  asm volatile("s_waitcnt lgkmcnt(0)\n\ts_barrier":::"memory");
  #undef DMA_K
  #undef DMA_V
  #undef CMASK
  #undef START
  #undef RESC
  #undef ROT
}
__device__ __forceinline__ void attn_finish(int b,int h,int qb,bf16*YB,const float*g,float out_scale,char*shm,int wave_){
  const int tid_=fresh_tid(wave_); const int lane=tid_&63; const int wid=__builtin_amdgcn_readfirstlane(tid_>>6);
  asm volatile("s_waitcnt lgkmcnt(0)":::"memory");
  const bf16*stg=(const bf16*)(shm+LDS_OST)+wid*4096; const int ch=lane&15;
  const f32x4 g0=*(const f32x4*)(g+ch*8),g1=*(const f32x4*)(g+ch*8+4);
  const size_t rowb=(size_t)b*SEQ+(size_t)qb*QB+wid*QBLK;
  #pragma unroll
  for(int i=0;i<8;++i){const int row=i*4+(lane>>4);
    const u32x4 v=*(const u32x4*)(stg+row*128+ch*8);
    const float x0=bflo(v.x),x1=bfhi(v.x),x2=bflo(v.y),x3=bfhi(v.y),x4=bflo(v.z),x5=bfhi(v.z),x6=bflo(v.w),x7=bfhi(v.w);
    float ss=(x0*x0+x1*x1)+(x2*x2+x3*x3)+(x4*x4+x5*x5)+(x6*x6+x7*x7);
    ss+=__shfl_xor(ss,1);ss+=__shfl_xor(ss,2);ss+=__shfl_xor(ss,4);ss+=__shfl_xor(ss,8);
    const float rs=out_scale/sqrtf(ss*(1.f/128.f)+EPS);
    u32x4 o;o.x=pk2(x0*rs*g0[0],x1*rs*g0[1]);o.y=pk2(x2*rs*g0[2],x3*rs*g0[3]);o.z=pk2(x4*rs*g1[0],x5*rs*g1[1]);o.w=pk2(x6*rs*g1[2],x7*rs*g1[3]);
    *(u32x4*)(YB+(rowb+row)*1024+h*128+ch*8)=o;}
  asm volatile("s_waitcnt lgkmcnt(0)":::"memory");
}
__device__ __forceinline__ void attn_finish_half(int b,int h,int qb,int vh,bf16*YB,const float*g,float out_scale,unsigned long long*xh,char*shm,int wave_){
  const int tid_=fresh_tid(wave_); const int lane=tid_&63; const int wid=__builtin_amdgcn_readfirstlane(tid_>>6);
  asm volatile("s_waitcnt lgkmcnt(0)":::"memory");
  const bf16*stg=(const bf16*)(shm+LDS_OST)+wid*4096; const int ch=lane&7;
  float x[4][8],ss[4];
  #pragma unroll
  for(int i=0;i<4;++i){const int row=i*8+(lane>>3);
    unpack8(*(const u32x4*)(stg+row*128+vh*64+ch*8),x[i]);
    float q=0.f;
    #pragma unroll
    for(int e=0;e<8;++e)q+=x[i][e]*x[i][e];
    q+=__shfl_xor(q,1);q+=__shfl_xor(q,2);q+=__shfl_xor(q,4);ss[i]=q;
    if(ch==0)__hip_atomic_store(xh+vh*256+wid*32+row,(1ull<<32)|(unsigned long long)__float_as_uint(q),__ATOMIC_RELAXED,__HIP_MEMORY_SCOPE_AGENT);}
  const f32x4 g0=*(const f32x4*)(g+vh*64+ch*8),g1=*(const f32x4*)(g+vh*64+ch*8+4);
  const size_t rowb=(size_t)b*SEQ+(size_t)qb*QB+wid*QBLK;
  #pragma unroll
  for(int i=0;i<4;++i){const int row=i*8+(lane>>3);
    unsigned long long pv=0ull;
    #pragma unroll 1
    for(unsigned it=0;it<(1u<<20);++it){pv=__hip_atomic_load(xh+(vh^1)*256+wid*32+row,__ATOMIC_RELAXED,__HIP_MEMORY_SCOPE_AGENT); if((pv>>32)!=0ull)break; __builtin_amdgcn_s_sleep(1);}
    const float tot=ss[i]+__uint_as_float((unsigned)pv);
    const float rs=out_scale/sqrtf(tot*(1.f/128.f)+EPS);
    u32x4 o;o.x=pk2(x[i][0]*rs*g0[0],x[i][1]*rs*g0[1]);o.y=pk2(x[i][2]*rs*g0[2],x[i][3]*rs*g0[3]);o.z=pk2(x[i][4]*rs*g1[0],x[i][5]*rs*g1[1]);o.w=pk2(x[i][6]*rs*g1[2],x[i][7]*rs*g1[3]);
    *(u32x4*)(YB+(rowb+row)*1024+h*128+vh*64+ch*8)=o;}
  asm volatile("s_waitcnt lgkmcnt(0)":::"memory");
}
constexpr int ATTN_LDS_BYTES=LDS_BYTES;
#undef SBAR
#undef WAIT_BAR
}

#define LAS __attribute__((address_space(3)))
constexpr size_t WS_CTL = 242 * MiB, CTL_ZERO_BYTES = 32768;
constexpr int LDSCTL_OFF = 131072, MISC_OFF = LDSCTL_OFF + 320;
#define XB_TMO      128
#define XB_XCNT(j)  (256  + 64 * (j))
#define XB_XSUB(j)  (1280 + 64 * (j))
#define XB_XGEN(j)  (2304 + 64 * (j))
#define XB_TOP      3328
#define XB_TOPGEN   3392
#define XCD_BAR_WORDS 3456
#define XB_SPIN_CAP (1u << 18)

__device__ __forceinline__ unsigned xb_ld(unsigned* p)              { return __hip_atomic_load(p, __ATOMIC_RELAXED, __HIP_MEMORY_SCOPE_AGENT); }
__device__ __forceinline__ unsigned xb_add(unsigned* p, unsigned v) { return __hip_atomic_fetch_add(p, v, __ATOMIC_RELAXED, __HIP_MEMORY_SCOPE_AGENT); }
__device__ __forceinline__ unsigned xb_xcc_id() { return (unsigned)__builtin_amdgcn_s_getreg((3 << 11) | 20) & 0xFu; }
#define XB_SPIN(cond, bar) do { unsigned _sp = 0; while (cond) { __builtin_amdgcn_s_sleep(1); \
    if ((++_sp & 255u) == 0u) { if (xb_ld(&(bar)[XB_TMO])) break; if (_sp > XB_SPIN_CAP) { atomicAdd(&(bar)[XB_TMO], 1u); break; } } } } while (0)

struct XcdBarrier {
    unsigned* bar; unsigned x;
    volatile LAS unsigned* st;
};

__device__ __forceinline__ XcdBarrier xcd_barrier_post(unsigned* bar, volatile LAS unsigned* st) {
    XcdBarrier b; b.bar = bar; b.x = xb_xcc_id(); b.st = st;
    if (threadIdx.x == 0) { st[3] = xb_add(&bar[XB_XCNT(b.x)], 1u); st[2] = blockIdx.x; }
    return b;
}
__device__ __forceinline__ void xcd_barrier_complete(unsigned* bar, unsigned x, unsigned& nloc, unsigned& nx) {
    const unsigned G = gridDim.x * gridDim.y * gridDim.z;
    unsigned sum, cnt, mine, sp = 0u;
    for (;;) {
        sum = 0u; cnt = 0u; mine = 0u;
#pragma unroll
        for (unsigned j = 0; j < 16; ++j) { const unsigned c = xb_ld(&bar[XB_XCNT(j)]); sum += c; cnt += (c > 0u) ? 1u : 0u; mine = (j == x) ? c : mine; }
        if (sum == G) break;
        __builtin_amdgcn_s_sleep(1);
        if ((++sp & 255u) == 0u) { if (xb_ld(&bar[XB_TMO])) break; if (sp > XB_SPIN_CAP) { atomicAdd(&bar[XB_TMO], 1u); break; } }
    }
    nloc = mine > 0u ? mine : 1u; nx = cnt > 0u ? cnt : 1u;
}

__device__ __forceinline__ void xcd_barrier(const XcdBarrier& b, bool thread0) {
    asm volatile("s_waitcnt vmcnt(0)" ::: "memory");
    __syncthreads();
    if (thread0) {
        unsigned* bar = b.bar;
        __builtin_amdgcn_s_waitcnt(0);
        unsigned nloc = b.st[0], nx = b.st[1];
        if (nloc == 0u) { xcd_barrier_complete(bar, b.x, nloc, nx); b.st[0] = nloc; b.st[1] = nx; }
        const unsigned old = xb_add(&bar[XB_XSUB(b.x)], 1u);
        const unsigned gen = old / nloc;
        if (old + 1u == (gen + 1u) * nloc) {
            __builtin_amdgcn_fence(__ATOMIC_RELEASE, "agent");
            asm volatile("s_waitcnt vmcnt(0)" ::: "memory");
            const unsigned og = xb_add(&bar[XB_TOP], 1u);
            const unsigned tg = og / nx;
            if (og + 1u == (tg + 1u) * nx) xb_add(&bar[XB_TOPGEN], 1u);
            else XB_SPIN(xb_ld(&bar[XB_TOPGEN]) == tg, bar);
            __builtin_amdgcn_fence(__ATOMIC_ACQUIRE, "agent");
            xb_add(&bar[XB_XGEN(b.x)], 1u);
            asm volatile("s_waitcnt vmcnt(0)" ::: "memory");
        } else {
            XB_SPIN(xb_ld(&bar[XB_XGEN(b.x)]) == gen, bar);
            __builtin_amdgcn_fence(__ATOMIC_ACQUIRE, "agent");
            asm volatile("s_waitcnt vmcnt(0)" ::: "memory");
        }
    }
    __syncthreads();
}

#define XB_XSUB2(j) (4096 + 64 * (j))
#define XB_XGEN2(j) (4608 + 64 * (j))
#define XB_TOP4 5184
#define XB_TOP3 5120
__device__ __forceinline__ void xcc_barrier(unsigned* bar, unsigned x, bool thread0, bool arrive_top, unsigned wait_top, int top_word) {
    asm volatile("s_waitcnt vmcnt(0)" ::: "memory");
    __syncthreads();
    if (thread0) {
        __builtin_amdgcn_s_waitcnt(0);
        const unsigned old = xb_add(&bar[XB_XSUB2(x)], 1u);
        const unsigned gen = old / 32u;
        if (old + 1u == (gen + 1u) * 32u) {
            __builtin_amdgcn_fence(__ATOMIC_RELEASE, "agent");
            asm volatile("s_waitcnt vmcnt(0)" ::: "memory");
            if (arrive_top) xb_add(&bar[top_word], 1u);
            if (wait_top != 0u) XB_SPIN(xb_ld(&bar[top_word]) < wait_top, bar);
            __builtin_amdgcn_fence(__ATOMIC_ACQUIRE, "agent");
            xb_add(&bar[XB_XGEN2(x)], 1u);
            asm volatile("s_waitcnt vmcnt(0)" ::: "memory");
        } else {
            XB_SPIN(xb_ld(&bar[XB_XGEN2(x)]) == gen, bar);
            __builtin_amdgcn_fence(__ATOMIC_ACQUIRE, "agent");
            asm volatile("s_waitcnt vmcnt(0)" ::: "memory");
        }
    }
    __syncthreads();
}

struct Args { const float* in[21]; float* out; unsigned char* ws; };
#define GRID_SYNC() do { XcdBarrier bar_; bar_.bar = (unsigned*)(ws + WS_CTL); bar_.x = xb_xcc_id(); bar_.st = (volatile LAS unsigned*)((LAS unsigned char*)lds + MISC_OFF) + 8; xcd_barrier(bar_, fresh_tid(my_wave) == 0); } while (0)
#define LOCAL_SYNC_EX(arrive_, wait_) LOCAL_SYNC_EX2(arrive_, wait_, XB_TOP3)
#define LOCAL_SYNC_EX2(arrive_, wait_, topw_) do { unsigned z_ = 0u; asm volatile("" : "+v"(z_)); LAS unsigned* fa_ = (LAS unsigned*)((LAS unsigned char*)lds + MISC_OFF + z_) + 12; \
        if (__builtin_amdgcn_readfirstlane(*(volatile LAS unsigned*)fa_) != 0u) xcc_barrier((unsigned*)(ws + WS_CTL), xb_xcc_id(), fresh_tid(my_wave) == 0, (arrive_), (wait_), (topw_)); else GRID_SYNC(); } while (0)
#define LOCAL_SYNC() LOCAL_SYNC_EX(false, 0u)

__global__ void __launch_bounds__(NTHR, 2) fwd_megakernel(Args args) {
    extern __shared__ __attribute__((aligned(16))) unsigned char lds[];
    cg::grid_group grid = cg::this_grid();
    const int my_wave = __builtin_amdgcn_readfirstlane(threadIdx.x >> 6);
    Ctx C;
    typedef const __attribute__((address_space(4))) unsigned long long* kargp_t;
    kargp_t kp;
#define FRESH_CTX() do { const int t_ = fresh_tid(my_wave); C.lds = lds; C.tid = t_; C.lane = t_ & 63; C.wave = __builtin_amdgcn_readfirstlane(t_ >> 6); \
        C.gw = blockIdx.x * NWAVES + C.wave; C.ngw = gridDim.x * NWAVES; kp = (kargp_t)__builtin_amdgcn_kernarg_segment_ptr(); asm volatile("" : "+s"(kp)); G = gridDim.x; { unsigned z_ = 0u; asm volatile("" : "+v"(z_)); LAS unsigned* ra_ = (LAS unsigned*)((LAS unsigned char*)lds + MISC_OFF + z_) + 10; bid = (int)__builtin_amdgcn_readfirstlane(*(volatile LAS unsigned*)ra_); } asm volatile("" : "+s"(G), "+s"(bid)); } while (0)
#define GASP __attribute__((address_space(1)))
#define IN(k) ((const float*)(const GASP float*)kp[k])
#define xout ((float*)(GASP float*)kp[21])
#define ws ((unsigned char*)(GASP unsigned char*)kp[22])
#define x_in IN(0)
#define ZA ((bf16_t*)(ws + WS_ZA))
#define QKV ((bf16_t*)(ws + WS_QKV))
#define ZC ((bf16_t*)(ws + WS_ZC))
#define GB ((bf16_t*)(ws + WS_G))
#define G8B ((unsigned char*)(ws + WS_G))
#define H8B ((G == 256) ? (unsigned char*)xout + 32 * MiB : (unsigned char*)(ws + WS_MG))
#define MGB ((bf16_t*)(ws + WS_MG))
#define HB ((bf16_t*)(ws + WS_H))
#define PB ((float*)(ws + WS_P))
    int G, bid;
    FRESH_CTX();
    for (int u = C.tid; u < (LDS_BYTES - LDSCTL_OFF) / 4; u += NTHR) ((LAS unsigned*)((LAS unsigned char*)lds + LDSCTL_OFF))[u] = 0u;
    __syncthreads();
    (void)xcd_barrier_post((unsigned*)(ws + WS_CTL), (volatile LAS unsigned*)((LAS unsigned char*)lds + MISC_OFF) + 8);
    __syncthreads();
    FRESH_CTX();
    if (G == 0x7fffffff) grid.sync();

    convert_mixer_weights(C, IN(2), IN(14), IN(15), IN(12), ws);
    for (int m = C.gw; m < MTOK; m += 4 * C.ngw) rms_rows4_to_bf16(x_in, IN(1), HB, H8B, m, C.ngw, C.lane);
    { u32x4* z = (u32x4*)(ws + WS_XH); const int nz = (int)((2 * MiB) / 16);
      for (int i = (bid * NTHR + C.tid); i < nz; i += G * NTHR) z[i] = (u32x4){0u, 0u, 0u, 0u};
      u32x4* z2 = (u32x4*)(ws + WS_XS); const int nz2 = (int)((8 * XS_BANK) / 16);
      for (int i = (bid * NTHR + C.tid); i < nz2; i += G * NTHR) z2[i] = (u32x4){0u, 0u, 0u, 0u}; }
    GRID_SYNC();
    if (fresh_tid(my_wave) == 0) {
        volatile LAS unsigned* misc = (volatile LAS unsigned*)((LAS unsigned char*)lds + MISC_OFF);
        unsigned* barw = (unsigned*)(ws + WS_CTL); bool ok = (gridDim.x == 256);
#pragma unroll
        for (int j = 0; j < 8; ++j) ok = ok && (xb_ld(&barw[XB_XCNT(j)]) == 32u);
        const unsigned xme = xb_xcc_id();
        if (ok && xme < 8u) { misc[10] = misc[11] * 8u + xme; misc[12] = 1u; }
    }
    __syncthreads();

#pragma unroll 1
    for (int l = 0; l < 2; ++l) {

        FRESH_CTX();
        { Gemm g{1024, 1024}; StaticOrder S; S.init(MTOK, 3072, G, bid, HB, 1024, (const bf16_t*)(ws + WS_WIN), 1024);
          EpiIn E{ZA, QKV, ZC};
          GEMM_PHASE(EpiIn, StaticOrder, g, S, E); }
        FRESH_CTX();
        { Gemm g{512, 512}; StaticOrder S; S.init(MTOK, 3072, G, bid, (const bf16_t*)H8B, 512, (const bf16_t*)(ws + WS_WG8), 512);
          EpiGate E{G8B};
          GEMM_PHASE(EpiGate, StaticOrder, g, S, E); }
        GRID_SYNC();
        FRESH_CTX();
        { const float linit = 0.8f - 0.6f * expf(-0.3f * (float)l);
          const float d1 = wave_sum(IN(7)[l * 64 + C.lane] * IN(8)[l * 64 + C.lane]), d2 = wave_sum(IN(9)[l * 64 + C.lane] * IN(10)[l * 64 + C.lane]);
          const float lam = expf(d1) - expf(d2) + linit;
          const int vcu = (G % 8 == 0) ? (bid % 8) * (G / 8) + bid / 8 : bid;
#define MIX_LIGHT(u_) do { const int uu_ = (u_); if (uu_ & 1) pool_unit(C, uu_ >> 1, ZC, (const bf16_t*)(ws + WS_WPOOL), IN(13) + l * 512, HB); \
              else gmlp_unit(C, uu_ >> 1, ZA, IN(3) + l * 512, IN(4) + l * 512, IN(5) + (size_t)l * 4 * 128 * 128, IN(6) + l * 512); } while (0)
          int njobs, jgrp, jq0, jq1, jvlo, jvhi, jstep, side_pos = -1;
          if (G == 256) {
              const int sx = vcu & 7, kx = sx & 3;
              side_pos = (vcu >> 3) % 3;
              njobs = 2; jgrp = vcu >> 3; jq0 = 7 - kx; jq1 = kx; jvlo = jvhi = sx >> 2; jstep = 0;
          } else {
#pragma unroll 1
              for (int u = bid; u < 1024; u += G) MIX_LIGHT(u);
              njobs = (256 - bid + G - 1) / G; jgrp = 0; jq0 = 0; jq1 = 0; jvlo = 0; jvhi = 1; jstep = G;
          }
#define MIX_SIDE() do { __syncthreads(); FRESH_CTX(); \
              convert_ffn_weights(C, IN(18) + (size_t)l * 1024 * 2 * DFF, IN(19) + (size_t)l * DFF * 1024, ws); __syncthreads(); \
              _Pragma("unroll 1") for (int jl_ = 0; jl_ < 4; ++jl_) MIX_LIGHT(((G % 8 == 0) ? (bid % 8) * (G / 8) + bid / 8 : bid) * 4 + jl_); } while (0)
#pragma unroll 1
          for (int j = 0; j <= njobs; ++j) {
              if (j == side_pos) MIX_SIDE();
              if (j == njobs) break;
              int grp_, qb_;
              if (jstep == 0) { grp_ = jgrp; qb_ = (j == 0) ? jq0 : jq1; } else { const int a = bid + j * jstep; grp_ = a >> 3; qb_ = a & 7; }
              const int b_ = grp_ >> 2, h_ = grp_ & 3;
#pragma unroll 1
              for (int p_ = 2 * jvlo; p_ < 2 * jvhi + 2; ++p_) { const int c_ = p_ & 1, vh_ = p_ >> 1;
                  attn_body::attn_unit<8>(b_, qb_, QKV + h_ * 128 + c_ * 64, QKV + 512 + h_ * 128 + c_ * 64, QKV + 1024 + h_ * 128 + vh_ * 64, c_, vh_, lam, (char*)lds, my_wave); }
              if (jvlo == jvhi) attn_body::attn_finish_half(b_, h_, qb_, jvlo, HB, IN(11) + l * 128, 1.0f - linit, (unsigned long long*)(ws + WS_XH) + ((size_t)(l * 32 + grp_) * 8 + qb_) * 512, (char*)lds, my_wave);
              else attn_body::attn_finish(b_, h_, qb_, HB, IN(11) + l * 128, 1.0f - linit, (char*)lds, my_wave);
          }
#undef MIX_SIDE
#undef MIX_LIGHT
        }
        LOCAL_SYNC_EX(true, 0u);
        FRESH_CTX();
        if (G != 256) convert_ffn_weights(C, IN(18) + (size_t)l * 1024 * 2 * DFF, IN(19) + (size_t)l * DFF * 1024, ws);
        __syncthreads();
        FRESH_CTX();
        { Gemm g{1024, 512}; BranchOrder S; S.so.init(MTOK, 1024, G, bid, nullptr, 1024, nullptr, 512);
          S.A0 = ZA; S.Bt = (const bf16_t*)(ws + WS_WB); S.bstride = (size_t)1024 * 512;
          EpiBranch E{G8B, MGB};
          GEMM_PHASE(EpiBranch, BranchOrder, g, S, E); }
        LOCAL_SYNC();
        if (G == 256) {
            FRESH_CTX();
            { Gemm g{1024, 1024}; StaticOrder S; S.init(MTOK, 1024, G, bid, MGB, 1024, (const bf16_t*)(ws + WS_WOUT), 1024);
              const PanelRms p1{(unsigned long long*)(ws + WS_XS + (size_t)(4 * l + 0) * XS_BANK)}, p2{(unsigned long long*)(ws + WS_XS + (size_t)(4 * l + 1) * XS_BANK)};
              if (l == 0) { EpiRmsRes<false> E{x_in, nullptr, ZA, IN(16) + l * DM, IN(17) + l * DM, HB, nullptr, p1, p2}; GEMM_PHASE(EpiRmsRes<false>, StaticOrder, g, S, E); }
              else { EpiRmsRes<true> E{(const bf16_t*)xout, nullptr, ZA, IN(16) + l * DM, IN(17) + l * DM, HB, nullptr, p1, p2}; GEMM_PHASE(EpiRmsRes<true>, StaticOrder, g, S, E); } }
            LOCAL_SYNC_EX(false, 8u * (unsigned)(l + 1));
        } else {
            FRESH_CTX();
            { Gemm g{1024, 1024}; StaticOrder S; S.init(MTOK, 1024, G, bid, MGB, 1024, (const bf16_t*)(ws + WS_WOUT), 1024);
              EpiF32 E{PB};
              GEMM_PHASE(EpiF32, StaticOrder, g, S, E); }
            GRID_SYNC();
            FRESH_CTX();
            for (int m = C.gw; m < MTOK; m += C.ngw)
                res_norm_row(PB + (size_t)m * DM, ((l == 0) ? x_in : (const float*)xout) + (size_t)m * DM, xout + (size_t)m * DM, IN(16) + l * DM, IN(17) + l * DM, HB + (size_t)m * DM, nullptr, C.lane);
            GRID_SYNC();
        }
        FRESH_CTX();
        { Gemm g{1024, 1024}; StaticOrder S; S.init(MTOK, 2 * DFF, G, bid, HB, 1024, (const bf16_t*)(ws + WS_WF1), 1024);
          EpiSwiglu E{GB};
          GEMM_PHASE(EpiSwiglu, StaticOrder, g, S, E); }
        if (l == 0) LOCAL_SYNC_EX2(true, 0u, XB_TOP4); else GRID_SYNC();
        FRESH_CTX();
        bool lm7; { unsigned z_ = 0u; asm volatile("" : "+v"(z_)); LAS unsigned* fa_ = (LAS unsigned*)((LAS unsigned char*)lds + MISC_OFF + z_) + 12; lm7 = __builtin_amdgcn_readfirstlane(*(volatile LAS unsigned*)fa_) != 0u; }
        if (l == 0 && !lm7) convert_mixer_weights(C, IN(2) + (size_t)1024 * IN_TOTAL, IN(14) + (size_t)3 * 512 * 1024, IN(15) + (size_t)1024 * 1024, IN(12) + (size_t)4 * 128 * 128, ws);
        __syncthreads();
        if (G == 256) {
            FRESH_CTX();
            { Gemm g{DFF, DFF}; StaticOrder S; S.init(MTOK, 1024, G, bid, GB, DFF, (const bf16_t*)(ws + WS_WF2), DFF);
              const PanelRms p1{(unsigned long long*)(ws + WS_XS + (size_t)(4 * l + 2) * XS_BANK)}, p2{(unsigned long long*)(ws + WS_XS + (size_t)(4 * l + 3) * XS_BANK)};
              EpiRmsRes<true> E{ZA, (l == 0) ? nullptr : xout, (bf16_t*)xout, IN(20) + l * DM, (l == 0) ? IN(1) + DM : nullptr, HB, H8B, p1, p2};
              GEMM_PHASE(EpiRmsRes<true>, StaticOrder, g, S, E); }
        } else {
            FRESH_CTX();
            { Gemm g{DFF, DFF}; StaticOrder S; S.init(MTOK, 1024, G, bid, GB, DFF, (const bf16_t*)(ws + WS_WF2), DFF);
              EpiF32 E{PB};
              GEMM_PHASE(EpiF32, StaticOrder, g, S, E); }
            GRID_SYNC();
            FRESH_CTX();
            for (int m = C.gw; m < MTOK; m += C.ngw)
                res_norm_row(PB + (size_t)m * DM, xout + (size_t)m * DM, xout + (size_t)m * DM, IN(20) + l * DM, (l == 0) ? IN(1) + DM : nullptr, HB + (size_t)m * DM, H8B + (size_t)m * DM, C.lane);
        }
        if (l == 0) {
            FRESH_CTX();
            bool lm8; { unsigned z_ = 0u; asm volatile("" : "+v"(z_)); LAS unsigned* fa_ = (LAS unsigned*)((LAS unsigned char*)lds + MISC_OFF + z_) + 12; lm8 = __builtin_amdgcn_readfirstlane(*(volatile LAS unsigned*)fa_) != 0u; }
            if (lm8) {
                if (C.tid == 0) { unsigned* barw = (unsigned*)(ws + WS_CTL); XB_SPIN(xb_ld(&barw[XB_TOP4]) < 8u, barw); }
                __syncthreads();
                convert_mixer_weights(C, IN(2) + (size_t)1024 * IN_TOTAL, IN(14) + (size_t)3 * 512 * 1024, IN(15) + (size_t)1024 * 1024, IN(12) + (size_t)4 * 128 * 128, ws);
            }
            GRID_SYNC();
        }
    }
}

#undef IN
#undef xout
#undef ws
#undef x_in
#undef ZA
#undef QKV
#undef ZC
#undef GB
#undef G8B
#undef H8B
#undef MGB
#undef HB
#undef PB
extern "C" void kernel_launch(void* const* d_in, const int* in_sizes, int n_in, void* d_out, int out_size, void* d_ws, size_t ws_size, hipStream_t stream) {
    static int grid = 0;
    if (grid == 0) {
        if (n_in != 21 || out_size != MTOK * DM || ws_size < WS_END) { fprintf(stderr, "kernel_launch: unexpected problem (n_in %d out %d ws %zu)\n", n_in, out_size, ws_size); grid = -1; return; }
        int dev = 0, cus = 0, per_cu = 0;
        hipGetDevice(&dev); hipDeviceGetAttribute(&cus, hipDeviceAttributeMultiprocessorCount, dev);
        hipFuncSetAttribute((const void*)fwd_megakernel, hipFuncAttributeMaxDynamicSharedMemorySize, LDS_BYTES);
        hipOccupancyMaxActiveBlocksPerMultiprocessor(&per_cu, (const void*)fwd_megakernel, NTHR, LDS_BYTES);
        if (per_cu < 1) { fprintf(stderr, "kernel_launch: occupancy query says %d\n", per_cu); per_cu = 1; }
        (void)hipGetLastError();
        grid = cus * 1;
    }
    if (grid < 0) return;
    if (hipMemsetAsync((char*)d_ws + WS_CTL, 0, CTL_ZERO_BYTES, stream) != hipSuccess) { fprintf(stderr, "kernel_launch: memset of the barrier words failed\n"); return; }
    Args a{};
    for (int i = 0; i < 21; ++i) a.in[i] = (const float*)d_in[i];
    a.out = (float*)d_out; a.ws = (unsigned char*)d_ws;
    void* kargs[] = {&a};
    hipError_t e = hipLaunchCooperativeKernel((const void*)fwd_megakernel, dim3(grid), dim3(NTHR), kargs, LDS_BYTES, stream);
    if (e != hipSuccess) fprintf(stderr, "cooperative launch failed: %s (grid %d)\n", hipGetErrorString(e), grid);
}
```
